# Optimizing an MI355X kernel written in HIP

```python
import jax, jax.numpy as jnp
from jax import lax
import numpy as np

D_MODEL = 1024
BATCH = 8
SEQ = 2048
DEPTH = 1

RMS_EPS = 1e-6
HG_HEADS = 4
HG_DK = 128
HG_DV = 128
HG_WIDTH = 512
HG_CHUNK = 64
RW_HEADS = 8
RW_HEAD = 64
RW_WIDTH = 512
RW_DECAY_LORA = 64
RW_AAA_LORA = 64
RW_GATE_LORA = 128
RW_GN_EPS = 64e-5
RW_COLS = 1792
IN_WIDTHS = (512, 512, 512, 512, 1792, 1024, 1024)
IN_COLS = 5888
PK_HEADS = 8
PK_DIM = 128
PK_HALF = 64
N_KEYS = 128
N_EXPERTS = 16384
PK_TOPK = 16
PEER_BLOCK = 128
PLE_DIM = 256

kernel_name = "hgrn2_rwkv7_peer_hybrid_block"


def rms_norm(x, w):
    xf = x.astype(jnp.float32)
    y = xf * lax.rsqrt(jnp.mean(xf * xf, axis=-1, keepdims=True) + RMS_EPS)
    return (y * w.astype(jnp.float32)).astype(x.dtype)


def split_cols(cols, widths):
    out, start = [], 0
    for wd in widths:
        out.append(cols[..., start:start + wd])
        start += wd
    return out


def hgrn2_mixer(q, f_logit, i_val, g_out, lb, norm_w):
    B, S, _ = q.shape
    nc = S // HG_CHUNK
    f32 = jnp.float32
    q = jax.nn.silu(q.astype(f32)) * (HG_DK ** -0.5)
    f = lb + (1.0 - lb) * jax.nn.sigmoid(f_logit.astype(f32))
    log_f = jnp.log(f)
    k = 1.0 - f
    v = i_val.astype(f32)

    def to_chunks(t, d):
        return t.reshape(B, nc, HG_CHUNK, HG_HEADS, d).transpose(1, 0, 3, 2, 4)

    qc = to_chunks(q, HG_DK)
    kc = to_chunks(k, HG_DK)
    gc = to_chunks(log_f, HG_DK)
    vc = to_chunks(v, HG_DV)
    causal = jnp.tril(jnp.ones((HG_CHUNK, HG_CHUNK), dtype=bool))[:, :, None]

    def step(state, inp):
        q_c, k_c, v_c, g_c = inp
        b = jnp.cumsum(g_c, axis=2)
        o_inter = jnp.einsum('bhtk,bhkv->bhtv', q_c * jnp.exp(b), state)
        diff = b[:, :, :, None, :] - b[:, :, None, :, :]
        dec = jnp.where(causal, jnp.exp(jnp.where(causal, diff, 0.0)), 0.0)
        att = jnp.einsum('bhtk,bhsk,bhtsk->bhts', q_c, k_c, dec)
        o_intra = jnp.einsum('bhts,bhsv->bhtv', att, v_c)
        b_last = b[:, :, -1:, :]
        new_state = jnp.exp(b_last[:, :, 0, :])[..., None] * state + jnp.einsum('bhsk,bhsv->bhkv', k_c * jnp.exp(b_last - b), v_c)
        return new_state, o_inter + o_intra

    s0 = jnp.zeros((B, HG_HEADS, HG_DK, HG_DV), f32)
    _, o = lax.scan(step, s0, (qc, kc, vc, gc))
    o = o.transpose(1, 0, 3, 2, 4).reshape(B, S, HG_HEADS, HG_DV)
    o = o * lax.rsqrt(jnp.mean(o * o, axis=-1, keepdims=True) + RMS_EPS)
    o = o.reshape(B, S, HG_WIDTH) * norm_w.astype(f32) * jax.nn.silu(g_out.astype(f32))
    return o.astype(g_out.dtype)


def rwkv7_mixer(rw, mu, w0, w2, a0, a2, g2, k_k, k_a, r_k, ln_w, ln_b):
    B, S, _ = rw.shape
    f32 = jnp.float32
    prev = jnp.pad(rw, ((0, 0), (1, 0), (0, 0)))[:, :S]
    rw = rw + (prev - rw) * mu
    r, k, v, wd, ad, gd = split_cols(rw, (RW_WIDTH, RW_WIDTH, RW_WIDTH, RW_DECAY_LORA, RW_AAA_LORA, RW_GATE_LORA))
    w_log = -jax.nn.softplus(-(w0 + jnp.tanh(wd) @ w2).astype(f32)) - 0.5
    decay = jnp.exp(-jnp.exp(w_log))
    a = jax.nn.sigmoid((a0 + ad @ a2).astype(f32))
    g = (jax.nn.sigmoid(gd) @ g2).astype(f32)

    def heads(t):
        return t.astype(f32).reshape(B, S, RW_HEADS, RW_HEAD)

    r = heads(r)
    k = heads(k)
    v = heads(v)
    decay = heads(decay)
    a = heads(a)
    kk = k * k_k.astype(f32).reshape(RW_HEADS, RW_HEAD)
    kk = kk / jnp.maximum(jnp.sqrt(jnp.sum(kk * kk, axis=-1, keepdims=True)), 1e-12)
    k = k * (1.0 + (a - 1.0) * k_a.astype(f32).reshape(RW_HEADS, RW_HEAD))

    def step(state, inp):
        r_t, w_t, k_t, v_t, kk_t, a_t = inp
        sa = jnp.einsum('bhvk,bhk->bhv', state, kk_t)
        state = state * w_t[:, :, None, :] - sa[..., None] * (kk_t * a_t)[:, :, None, :] + v_t[..., None] * k_t[:, :, None, :]
        return state, jnp.einsum('bhvk,bhk->bhv', state, r_t)

    xs = (jnp.moveaxis(r, 1, 0), jnp.moveaxis(decay, 1, 0), jnp.moveaxis(k, 1, 0), jnp.moveaxis(v, 1, 0), jnp.moveaxis(kk, 1, 0), jnp.moveaxis(a, 1, 0))
    s0 = jnp.zeros((B, RW_HEADS, RW_HEAD, RW_HEAD), f32)
    _, y = lax.scan(step, s0, xs)
    y = jnp.moveaxis(y, 0, 1)
    mean = jnp.mean(y, axis=-1, keepdims=True)
    var = jnp.mean(jnp.square(y - mean), axis=-1, keepdims=True)
    y = ((y - mean) * lax.rsqrt(var + RW_GN_EPS)).reshape(B, S, RW_WIDTH) * ln_w.astype(f32) + ln_b.astype(f32)
    bonus = jnp.sum(r * k * r_k.astype(f32).reshape(RW_HEADS, RW_HEAD), axis=-1, keepdims=True) * v
    y = (y + bonus.reshape(B, S, RW_WIDTH)) * g
    return y.astype(rw.dtype)


def peer_ffn(h, wq, sub_keys, u_emb, v_emb):
    B, S, D = h.shape
    f32 = jnp.float32
    h_blocks = h.reshape(B * S // PEER_BLOCK, PEER_BLOCK, D)

    def block(hb):
        tb = hb.shape[0]
        q = (hb @ wq).reshape(tb, PK_HEADS, 2, PK_HALF)
        sc = jnp.einsum('thcd,cnd->thcn', q, sub_keys).astype(f32)
        s_top, i_top = lax.top_k(sc, PK_TOPK)
        cand = s_top[:, :, 0, :, None] + s_top[:, :, 1, None, :]
        c_s, c_i = lax.top_k(cand.reshape(tb, PK_HEADS, PK_TOPK * PK_TOPK), PK_TOPK)
        idx1 = jnp.take_along_axis(i_top[:, :, 0], c_i // PK_TOPK, axis=-1)
        idx2 = jnp.take_along_axis(i_top[:, :, 1], c_i % PK_TOPK, axis=-1)
        idx = idx1 * N_KEYS + idx2
        gate = jax.nn.softmax(c_s, axis=-1)
        u = jnp.take(u_emb, idx, axis=0)
        act = jax.nn.gelu(jnp.einsum('td,thkd->thk', hb, u).astype(f32), approximate=False)
        v_sel = jnp.take(v_emb, idx, axis=0)
        return jnp.einsum('thk,thkd->td', (gate * act).astype(hb.dtype), v_sel)

    return lax.map(block, h_blocks).reshape(B, S, D)


def setup_inputs(seed: int = 0) -> dict:
    key = jax.random.key(seed)
    ks = jax.random.split(key, 32)
    f32 = jnp.float32

    def nrm(k, shape, scale):
        return jax.random.normal(k, shape, f32) * scale

    def gain(k, shape):
        return 1.0 + 0.02 * jax.random.normal(k, shape, f32)

    return {
        "x": nrm(ks[0], (BATCH, SEQ, D_MODEL), 1.0),
        "p": nrm(ks[1], (DEPTH, BATCH, SEQ, PLE_DIM), 1.0),
        "norm_mix_w": gain(ks[2], (DEPTH, D_MODEL)),
        "w_in": nrm(ks[3], (DEPTH, D_MODEL, IN_COLS), D_MODEL ** -0.5),
        "hg_lb": nrm(ks[4], (DEPTH + 1, HG_WIDTH), 0.1),
        "hg_norm_w": gain(ks[5], (DEPTH, HG_WIDTH)),
        "rw_mu": jax.random.uniform(ks[6], (DEPTH, RW_COLS), f32),
        "rw_w0": jax.random.uniform(ks[7], (DEPTH, RW_WIDTH), f32, minval=-5.5, maxval=-0.5),
        "rw_w2": nrm(ks[8], (DEPTH, RW_DECAY_LORA, RW_WIDTH), 0.1),
        "rw_a0": nrm(ks[9], (DEPTH, RW_WIDTH), 0.1),
        "rw_a2": nrm(ks[10], (DEPTH, RW_AAA_LORA, RW_WIDTH), 0.1),
        "rw_g2": nrm(ks[11], (DEPTH, RW_GATE_LORA, RW_WIDTH), RW_GATE_LORA ** -0.5),
        "rw_k_k": 0.85 + nrm(ks[12], (DEPTH, RW_WIDTH), 0.02),
        "rw_k_a": gain(ks[13], (DEPTH, RW_WIDTH)),
        "rw_r_k": nrm(ks[14], (DEPTH, RW_WIDTH), 0.1),
        "rw_ln_w": gain(ks[15], (DEPTH, RW_WIDTH)),
        "rw_ln_b": nrm(ks[16], (DEPTH, RW_WIDTH), 0.02),
        "w_branch_hg": nrm(ks[17], (DEPTH, HG_WIDTH, D_MODEL), HG_WIDTH ** -0.5),
        "w_branch_rw": nrm(ks[18], (DEPTH, RW_WIDTH, D_MODEL), RW_WIDTH ** -0.5),
        "w_out": nrm(ks[19], (DEPTH, D_MODEL, D_MODEL), D_MODEL ** -0.5),
        "norm_ffn_w": gain(ks[20], (DEPTH, D_MODEL)),
        "peer_wq": nrm(ks[21], (DEPTH, D_MODEL, PK_HEADS * PK_DIM), D_MODEL ** -0.5),
        "peer_keys": nrm(ks[22], (DEPTH, 2, N_KEYS, PK_HALF), PK_HALF ** -0.5),
        "peer_u": nrm(ks[23], (DEPTH, N_EXPERTS, D_MODEL), D_MODEL ** -0.5),
        "peer_v": nrm(ks[24], (DEPTH, N_EXPERTS, D_MODEL), PK_HEADS ** -0.5),
        "norm_ple_w": gain(ks[25], (DEPTH, D_MODEL)),
        "ple_proj": nrm(ks[26], (DEPTH, PLE_DIM, D_MODEL), PLE_DIM ** -0.5),
        "ple_gate": nrm(ks[27], (DEPTH, D_MODEL, D_MODEL), D_MODEL ** -0.5),
        "final_norm_w": gain(ks[28], (D_MODEL,)),
    }


def reference(x, p, norm_mix_w, w_in, hg_lb, hg_norm_w, rw_mu, rw_w0, rw_w2, rw_a0, rw_a2, rw_g2, rw_k_k, rw_k_a, rw_r_k, rw_ln_w, rw_ln_b, w_branch_hg, w_branch_rw, w_out, norm_ffn_w, peer_wq, peer_keys, peer_u, peer_v, norm_ple_w, ple_proj, ple_gate, final_norm_w):
    lower_bounds = jnp.cumsum(jax.nn.softmax(hg_lb.astype(jnp.float32), axis=0), axis=0)
    for i in range(DEPTH):
        h = rms_norm(x, norm_mix_w[i])
        cols = h @ w_in[i]
        hq, hf, hi, hgo, rw_cols, gate_hg, gate_rw = split_cols(cols, IN_WIDTHS)
        y_hg = hgrn2_mixer(hq, hf, hi, hgo, lower_bounds[i], hg_norm_w[i])
        y_rw = rwkv7_mixer(rw_cols, rw_mu[i], rw_w0[i], rw_w2[i], rw_a0[i], rw_a2[i], rw_g2[i], rw_k_k[i], rw_k_a[i], rw_r_k[i], rw_ln_w[i], rw_ln_b[i])
        merged = jax.nn.sigmoid(gate_hg) * (y_hg @ w_branch_hg[i]) + jax.nn.sigmoid(gate_rw) * (y_rw @ w_branch_rw[i])
        x = x + merged @ w_out[i]
        x = x + peer_ffn(rms_norm(x, norm_ffn_w[i]), peer_wq[i], peer_keys[i], peer_u[i], peer_v[i])
        ple_g = jax.nn.sigmoid(rms_norm(x, norm_ple_w[i]) @ ple_gate[i])
        x = x + ple_g * (p[i] @ ple_proj[i])
    return rms_norm(x, final_norm_w)
```

```cpp
#include <hip/hip_runtime.h>
#include <cstdio>
#include <cstdint>

constexpr int D = 1024, BATCH = 8, SEQ = 2048, T = BATCH * SEQ;
constexpr int INC = 5888;
constexpr int HGW = 512, HGH = 4, HGD = 128;
constexpr int RWW = 512, RWH = 8, RWD = 64, RWC = 1792;
constexpr int NEXP = 16384, NKEYS = 128, PKH = 8, PKTOP = 16, PKHALF = 64;
constexpr int PLE = 256;
constexpr float RMS_EPS = 1e-6f, GN_EPS = 64e-5f;

typedef unsigned short bf16;
typedef unsigned v4u __attribute__((ext_vector_type(4)));
typedef unsigned v2u __attribute__((ext_vector_type(2)));
typedef float f32x4 __attribute__((ext_vector_type(4)));

constexpr size_t MiB = 1u << 20;
constexpr size_t WS_CTL = 0, CTL_ZERO_BYTES = 1 * MiB;
constexpr size_t CTL_SS2 = 256 * 1024, CTL_SS4 = 384 * 1024;
constexpr size_t WS_SMALL = 1 * MiB;
constexpr size_t SM_R1 = WS_SMALL, SM_R3 = WS_SMALL + 64 * 1024, SM_LB = WS_SMALL + 128 * 1024, SM_BONUS = WS_SMALL + 256 * 1024;
constexpr size_t WS_WIN = 2 * MiB;
constexpr size_t WS_WBH = 14 * MiB;
constexpr size_t WS_WBR = 15 * MiB;
constexpr size_t WS_WOUT = 16 * MiB;
constexpr size_t WS_WQ = 18 * MiB;
constexpr size_t WS_WPG = 20 * MiB;
constexpr size_t WS_WPP = 22 * MiB;
constexpr size_t WS_WLORA = 22 * MiB + 512 * 1024;
constexpr size_t WS_XB = 24 * MiB;
constexpr size_t WS_LW = WS_XB, WS_A = WS_XB + 16 * MiB, WS_YRW = WS_XB;
constexpr size_t WS_PB = 56 * MiB;
constexpr size_t WS_CQ = 64 * MiB;
constexpr size_t WS_M1 = WS_CQ, WS_MERGED = WS_CQ + 32 * MiB, WS_UT = WS_CQ, WS_VT = WS_CQ + 32 * MiB;
constexpr size_t WS_CRW = 128 * MiB;
constexpr size_t WS_G = WS_CRW, WS_HST = WS_CRW + 16 * MiB, WS_YRAW = WS_CRW + 36 * MiB, WS_IDX = WS_CRW, WS_GATE = WS_CRW + 8 * MiB;
constexpr size_t WS_CG = 184 * MiB;
constexpr size_t WS_X1B = WS_CG, WS_QP = WS_CG + 32 * MiB, WS_X2B = WS_CG, WS_T2 = WS_CG + 32 * MiB;
constexpr size_t WS_END = 256 * MiB;
constexpr size_t DO_R = 0, DO_K = 16 * MiB, DO_V = 32 * MiB, DO_LIN = 48 * MiB, DO_YHG = 48 * MiB;

__device__ __forceinline__ unsigned f2bf(float f) { unsigned u = __builtin_bit_cast(unsigned, f); return (u + 0x7fffu + ((u >> 16) & 1u)) >> 16; }
__device__ __forceinline__ unsigned pk2(float lo, float hi) { return f2bf(lo) | (f2bf(hi) << 16); }
__device__ __forceinline__ float bf2f(bf16 b) { return __builtin_bit_cast(float, ((unsigned)b) << 16); }
__device__ __forceinline__ float bflo(unsigned u) { return __builtin_bit_cast(float, u << 16); }
__device__ __forceinline__ float bfhi(unsigned u) { return __builtin_bit_cast(float, u & 0xffff0000u); }
__device__ __forceinline__ float sigmoidf_(float x) { return 1.f / (1.f + __expf(-x)); }
__device__ __forceinline__ float siluf_(float x) { return x / (1.f + __expf(-x)); }
__device__ __forceinline__ float wave_sum(float v) {
#pragma unroll
    for (int o = 1; o < 64; o <<= 1) v += __shfl_xor(v, o);
    return v;
}
__device__ __forceinline__ void unpack8(v4u w, float (&f)[8]) {
    f[0] = bflo(w.x); f[1] = bfhi(w.x); f[2] = bflo(w.y); f[3] = bfhi(w.y); f[4] = bflo(w.z); f[5] = bfhi(w.z); f[6] = bflo(w.w); f[7] = bfhi(w.w);
}
__device__ __forceinline__ v4u pack8(const float (&f)[8]) { v4u w; w.x = pk2(f[0], f[1]); w.y = pk2(f[2], f[3]); w.z = pk2(f[4], f[5]); w.w = pk2(f[6], f[7]); return w; }

struct EpiIn {
    const float* r1; const float* lb; bf16* cq; bf16* crw; bf16* cg;
    __device__ __forceinline__ void apply8(int row, int col0, float (&v)[8]) const {
        const float r = r1[row];
        float o[8];
        if (col0 < 512) {
#pragma unroll
            for (int j = 0; j < 8; ++j) o[j] = siluf_(v[j] * r) * 0.08838834764831845f;
            *(v4u*)(cq + (size_t)row * 2048 + col0) = pack8(o);
        } else if (col0 < 1024) {
#pragma unroll
            for (int j = 0; j < 8; ++j) { const float l = lb[col0 - 512 + j]; const float f = l + (1.f - l) * sigmoidf_(v[j] * r); o[j] = __logf(f); }
            *(v4u*)(cq + (size_t)row * 2048 + col0) = pack8(o);
        } else if (col0 < 1536) {
#pragma unroll
            for (int j = 0; j < 8; ++j) o[j] = v[j] * r;
            *(v4u*)(cq + (size_t)row * 2048 + col0) = pack8(o);
        } else if (col0 < 2048) {
#pragma unroll
            for (int j = 0; j < 8; ++j) o[j] = siluf_(v[j] * r);
            *(v4u*)(cq + (size_t)row * 2048 + col0) = pack8(o);
        } else if (col0 < 3840) {
#pragma unroll
            for (int j = 0; j < 8; ++j) o[j] = v[j] * r;
            *(v4u*)(crw + (size_t)row * RWC + (col0 - 2048)) = pack8(o);
        } else {
#pragma unroll
            for (int j = 0; j < 8; ++j) o[j] = sigmoidf_(v[j] * r);
            *(v4u*)(cg + (size_t)row * 2048 + (col0 - 3840)) = pack8(o);
        }
    }
};
struct EpiLora {
    const float* w0; const float* a0; bf16* lw; bf16* a; bf16* g;
    __device__ __forceinline__ void apply8(int row, int col0, float (&v)[8]) const {
        float o[8];
        if (col0 < 512) {
#pragma unroll
            for (int j = 0; j < 8; ++j) { const float z = -(w0[col0 + j] + v[j]); const float sp = fmaxf(z, 0.f) + log1pf(__expf(-fabsf(z))); o[j] = -__expf(-sp - 0.5f); }
            *(v4u*)(lw + (size_t)row * 512 + col0) = pack8(o);
        } else if (col0 < 1024) {
#pragma unroll
            for (int j = 0; j < 8; ++j) o[j] = sigmoidf_(a0[col0 - 512 + j] + v[j]);
            *(v4u*)(a + (size_t)row * 512 + col0 - 512) = pack8(o);
        } else {
            *(v4u*)(g + (size_t)row * 512 + col0 - 1024) = pack8(v);
        }
    }
};
struct EpiBranch1 {
    const bf16* cg; bf16* m1;
    __device__ __forceinline__ void apply8(int row, int col0, float (&v)[8]) const {
        float gt[8]; unpack8(*(const v4u*)(cg + (size_t)row * 2048 + col0), gt);
        float o[8];
#pragma unroll
        for (int j = 0; j < 8; ++j) o[j] = gt[j] * v[j];
        *(v4u*)(m1 + (size_t)row * 1024 + col0) = pack8(o);
    }
};
struct EpiBranch2 {
    const bf16* cg; const bf16* m1; bf16* mg;
    __device__ __forceinline__ void apply8(int row, int col0, float (&v)[8]) const {
        float gt[8], p[8]; unpack8(*(const v4u*)(cg + (size_t)row * 2048 + 1024 + col0), gt); unpack8(*(const v4u*)(m1 + (size_t)row * 1024 + col0), p);
        float o[8];
#pragma unroll
        for (int j = 0; j < 8; ++j) o[j] = p[j] + gt[j] * v[j];
        *(v4u*)(mg + (size_t)row * 1024 + col0) = pack8(o);
    }
};
struct EpiOut {
    const float* x; float* x1; bf16* x1b; float* ss2;
    __device__ __forceinline__ void apply8(int row, int col0, float (&v)[8]) const {
        const f32x4 a = *(const f32x4*)(x + (size_t)row * D + col0), b = *(const f32x4*)(x + (size_t)row * D + col0 + 4);
        float o[8] = {a.x + v[0], a.y + v[1], a.z + v[2], a.w + v[3], b.x + v[4], b.y + v[5], b.z + v[6], b.w + v[7]};
        *(f32x4*)(x1 + (size_t)row * D + col0) = (f32x4){o[0], o[1], o[2], o[3]};
        *(f32x4*)(x1 + (size_t)row * D + col0 + 4) = (f32x4){o[4], o[5], o[6], o[7]};
        *(v4u*)(x1b + (size_t)row * D + col0) = pack8(o);
        float s = 0.f;
#pragma unroll
        for (int j = 0; j < 8; ++j) s += o[j] * o[j];
        atomicAdd(ss2 + row, s);
    }
};
struct EpiQ {
    const float* ss2; bf16* qp;
    __device__ __forceinline__ void apply8(int row, int col0, float (&v)[8]) const {
        const float r = rsqrtf(ss2[row] * (1.f / D) + RMS_EPS);
        float o[8];
#pragma unroll
        for (int j = 0; j < 8; ++j) o[j] = v[j] * r;
        *(v4u*)(qp + (size_t)row * D + col0) = pack8(o);
    }
};
struct EpiPP {
    bf16* t2;
    __device__ __forceinline__ void apply8(int row, int col0, float (&v)[8]) const { *(v4u*)(t2 + (size_t)row * D + col0) = pack8(v); }
};
struct EpiPG {
    const float* r3; const bf16* t2; float* xio; float* ss4;
    __device__ __forceinline__ void apply8(int row, int col0, float (&v)[8]) const {
        const float r = r3[row];
        float t[8]; unpack8(*(const v4u*)(t2 + (size_t)row * D + col0), t);
        const f32x4 a = *(const f32x4*)(xio + (size_t)row * D + col0), b = *(const f32x4*)(xio + (size_t)row * D + col0 + 4);
        float xin[8] = {a.x, a.y, a.z, a.w, b.x, b.y, b.z, b.w}, o[8]; float s = 0.f;
#pragma unroll
        for (int j = 0; j < 8; ++j) { o[j] = xin[j] + sigmoidf_(v[j] * r) * t[j]; s += o[j] * o[j]; }
        *(f32x4*)(xio + (size_t)row * D + col0) = (f32x4){o[0], o[1], o[2], o[3]};
        *(f32x4*)(xio + (size_t)row * D + col0 + 4) = (f32x4){o[4], o[5], o[6], o[7]};
        atomicAdd(ss4 + row, s);
    }
};

template <class Epi> __global__ void __launch_bounds__(256) k_gemm_simple(const bf16* A, const bf16* Bt, int M, int N, int K, Epi E) {
    __shared__ float As[32][65], Bs[32][65];
    const int tid = threadIdx.x, tm = blockIdx.y * 64, tn = blockIdx.x * 64;
    const int ty = tid >> 3, tx = tid & 7;
    float acc[2][8];
#pragma unroll
    for (int i = 0; i < 2; ++i)
#pragma unroll
        for (int j = 0; j < 8; ++j) acc[i][j] = 0.f;
    const int lr = tid >> 2, lc = (tid & 3) * 8;
    for (int k0 = 0; k0 < K; k0 += 32) {
        float fa[8], fb[8];
        unpack8(*(const v4u*)(A + (size_t)(tm + lr) * K + k0 + lc), fa);
        unpack8(*(const v4u*)(Bt + (size_t)(tn + lr) * K + k0 + lc), fb);
#pragma unroll
        for (int j = 0; j < 8; ++j) { As[lc + j][lr] = fa[j]; Bs[lc + j][lr] = fb[j]; }
        __syncthreads();
#pragma unroll 8
        for (int kk = 0; kk < 32; ++kk) {
            const float a0 = As[kk][ty * 2], a1 = As[kk][ty * 2 + 1];
#pragma unroll
            for (int j = 0; j < 8; ++j) { const float b = Bs[kk][tx * 8 + j]; acc[0][j] += a0 * b; acc[1][j] += a1 * b; }
        }
        __syncthreads();
    }
    E.apply8(tm + ty * 2, tn + tx * 8, acc[0]);
    E.apply8(tm + ty * 2 + 1, tn + tx * 8, acc[1]);
}

__global__ void k_convT(const float* W, const float* sk, int K, int N, bf16* WT, int ldk, int koff, int row_off) {
    const size_t i = (size_t)blockIdx.x * blockDim.x + threadIdx.x;
    if (i >= (size_t)K * N) return;
    const int n = (int)(i / K), k = (int)(i % K);
    float v = W[(size_t)k * N + n]; if (sk) v *= sk[k];
    WT[(size_t)(row_off + n) * ldk + koff + k] = (bf16)f2bf(v);
}
__global__ void k_zero16(bf16* p, size_t n) { const size_t i = (size_t)blockIdx.x * blockDim.x + threadIdx.x; if (i < n) p[i] = 0; }
__global__ void k_conv(const float* s, bf16* d, size_t n8) {
    const size_t i = (size_t)blockIdx.x * blockDim.x + threadIdx.x;
    if (i >= n8) return;
    const f32x4 a = ((const f32x4*)s)[2 * i], b = ((const f32x4*)s)[2 * i + 1];
    v4u w; w.x = pk2(a.x, a.y); w.y = pk2(a.z, a.w); w.z = pk2(b.x, b.y); w.w = pk2(b.z, b.w);
    ((v4u*)d)[i] = w;
}
__global__ void k_lb(const float* hg_lb, float* lb) { const int c = blockIdx.x * blockDim.x + threadIdx.x; if (c < 512) { const float a = hg_lb[c], b = hg_lb[512 + c], m = fmaxf(a, b); const float ea = __expf(a - m), eb = __expf(b - m); lb[c] = ea / (ea + eb); } }
__global__ void __launch_bounds__(256) k_xprep(const float* x, bf16* xb, float* r1) {
    const int row = blockIdx.x * 4 + (threadIdx.x >> 6), lane = threadIdx.x & 63;
    const f32x4* xr = (const f32x4*)(x + (size_t)row * D) + lane;
    f32x4 v[4]; float s = 0.f;
#pragma unroll
    for (int j = 0; j < 4; ++j) { v[j] = xr[64 * j]; s += (v[j].x * v[j].x + v[j].y * v[j].y) + (v[j].z * v[j].z + v[j].w * v[j].w); }
    s = wave_sum(s);
    if (lane == 0) r1[row] = rsqrtf(s * (1.f / D) + RMS_EPS);
    v2u* o = (v2u*)(xb + (size_t)row * D) + lane;
#pragma unroll
    for (int j = 0; j < 4; ++j) { v2u w; w.x = pk2(v[j].x, v[j].y); w.y = pk2(v[j].z, v[j].w); o[64 * j] = w; }
}
__global__ void k_rwshift(const bf16* crw, const float* mu, bf16* R, bf16* Kk, bf16* V, bf16* lin) {
    const size_t i = (size_t)blockIdx.x * blockDim.x + threadIdx.x;
    if (i >= (size_t)T * RWC) return;
    const int t = (int)(i / RWC), c = (int)(i % RWC);
    const float cur = bf2f(crw[i]); const float prev = (t % SEQ) ? bf2f(crw[i - RWC]) : 0.f;
    const float v = cur + (prev - cur) * mu[c];
    if (c < 512) R[(size_t)t * 512 + c] = (bf16)f2bf(v);
    else if (c < 1024) Kk[(size_t)t * 512 + c - 512] = (bf16)f2bf(v);
    else if (c < 1536) V[(size_t)t * 512 + c - 1024] = (bf16)f2bf(v);
    else if (c < 1600) lin[(size_t)t * 256 + c - 1536] = (bf16)f2bf(tanhf(v));
    else if (c < 1664) lin[(size_t)t * 256 + c - 1536] = (bf16)f2bf(v);
    else lin[(size_t)t * 256 + c - 1536] = (bf16)f2bf(sigmoidf_(v));
}
__global__ void __launch_bounds__(128) k_hgrn_naive(const bf16* cq, const float* norm_w, bf16* yhg) {
    __shared__ float sq[128], sf[128], sk[128], red[2];
    const int b = blockIdx.x / HGH, h = blockIdx.x % HGH, v = threadIdx.x;
    float S[128];
#pragma unroll
    for (int k = 0; k < 128; ++k) S[k] = 0.f;
    const float nw = norm_w[h * 128 + v];
    for (int t = 0; t < SEQ; ++t) {
        const bf16* row = cq + (size_t)(b * SEQ + t) * 2048;
        sq[v] = bf2f(row[h * 128 + v]);
        const float f = __expf(bf2f(row[512 + h * 128 + v])); sf[v] = f; sk[v] = 1.f - f;
        const float vv = bf2f(row[1024 + h * 128 + v]); const float go = bf2f(row[1536 + h * 128 + v]);
        __syncthreads();
        float o = 0.f;
#pragma unroll
        for (int k = 0; k < 128; ++k) { S[k] = sf[k] * S[k] + sk[k] * vv; o += sq[k] * S[k]; }
        float s2 = wave_sum(o * o);
        if ((v & 63) == 0) red[v >> 6] = s2;
        __syncthreads();
        const float ms = (red[0] + red[1]) * (1.f / 128.f);
        yhg[(size_t)(b * SEQ + t) * 512 + h * 128 + v] = (bf16)f2bf(o * rsqrtf(ms + RMS_EPS) * nw * go);
    }
}
__global__ void __launch_bounds__(64) k_rwkv_naive(const bf16* R, const bf16* Kk, const bf16* V, const bf16* LW, const bf16* A, const float* k_k, const float* k_a, const float* r_k,
                                                   bf16* yraw, float* bonus) {
    __shared__ float sr[64], sw[64], sk[64], skk[64], sab[64];
    const int b = blockIdx.x / RWH, h = blockIdx.x % RWH, i = threadIdx.x, c = h * 64 + i;
    float S[64];
#pragma unroll
    for (int k = 0; k < 64; ++k) S[k] = 0.f;
    const float kkc = k_k[c], kac = k_a[c], rkc = r_k[c];
    for (int t = 0; t < SEQ; ++t) {
        const size_t o = (size_t)(b * SEQ + t) * 512 + c;
        const float r = bf2f(R[o]), k = bf2f(Kk[o]), v = bf2f(V[o]), a = bf2f(A[o]), w = __expf(bf2f(LW[o]));
        float kk = k * kkc; const float n2 = wave_sum(kk * kk); kk = kk / fmaxf(sqrtf(n2), 1e-12f);
        const float k2 = k * (1.f + (a - 1.f) * kac);
        const float bs = wave_sum(r * k2 * rkc);
        __syncthreads();
        sr[i] = r; sw[i] = w; sk[i] = k2; skk[i] = kk; sab[i] = kk * a;
        __syncthreads();
        float sa = 0.f;
#pragma unroll
        for (int j = 0; j < 64; ++j) sa += S[j] * skk[j];
        float y = 0.f;
#pragma unroll
        for (int j = 0; j < 64; ++j) { S[j] = S[j] * sw[j] - sa * sab[j] + v * sk[j]; y += S[j] * sr[j]; }
        yraw[o] = (bf16)f2bf(y);
        if (i == 0) bonus[(size_t)(b * SEQ + t) * 8 + h] = bs;
    }
}
__global__ void __launch_bounds__(256) k_rwpost(const bf16* yraw, const float* bonus, const bf16* V, const bf16* G, const float* ln_w, const float* ln_b, bf16* yrw) {
    const int w = blockIdx.x * 4 + (threadIdx.x >> 6), lane = threadIdx.x & 63;
    const int t = w / RWH, h = w % RWH, c = h * 64 + lane; const size_t o = (size_t)t * 512 + c;
    const float y = bf2f(yraw[o]);
    const float mean = wave_sum(y) * (1.f / 64.f); const float d = y - mean; const float var = wave_sum(d * d) * (1.f / 64.f);
    float r = d * rsqrtf(var + GN_EPS) * ln_w[c] + ln_b[c];
    r = (r + bonus[(size_t)t * 8 + h] * bf2f(V[o])) * bf2f(G[o]);
    yrw[o] = (bf16)f2bf(r);
}
__device__ __forceinline__ void topk_half(const bf16* qrow, const float* keysc, float* scr, float (&ts)[16], int (&ti)[16]) {
    float q[64];
#pragma unroll
    for (int d = 0; d < 64; ++d) q[d] = bf2f(qrow[d]);
    for (int n = 0; n < 128; ++n) { const float* kr = keysc + (size_t)n * 64; float s = 0.f;
#pragma unroll
        for (int d = 0; d < 64; ++d) s += q[d] * kr[d];
        scr[n] = s; }
#pragma unroll
    for (int k = 0; k < 16; ++k) { float m = -3.0e38f; int mi = 0; for (int n = 0; n < 128; ++n) { const float s = scr[n]; if (s > m) { m = s; mi = n; } } ts[k] = m; ti[k] = mi; scr[mi] = -3.0e38f; }
}
__global__ void __launch_bounds__(32) k_topk_naive(const bf16* qp, const float* keys, int* idx, float* gate) {
    __shared__ float sc[32][258];
    const int i = threadIdx.x, t = blockIdx.x * 4 + (i >> 3), h = i & 7;
    float ts0[16], ts1[16]; int ti0[16], ti1[16];
    topk_half(qp + (size_t)t * D + h * 128, keys, &sc[i][0], ts0, ti0);
    topk_half(qp + (size_t)t * D + h * 128 + 64, keys + 128 * 64, &sc[i][0], ts1, ti1);
#pragma unroll
    for (int a = 0; a < 16; ++a)
#pragma unroll
        for (int b2 = 0; b2 < 16; ++b2) sc[i][a * 16 + b2] = ts0[a] + ts1[b2];
    float cs[16]; int cidx[16];
#pragma unroll
    for (int k = 0; k < 16; ++k) { float m = -3.0e38f; int mi = 0; for (int n = 0; n < 256; ++n) { const float s = sc[i][n]; if (s > m) { m = s; mi = n; } } cs[k] = m; cidx[k] = mi; sc[i][mi] = -3.0e38f; }
    float den = 0.f; const float c0 = cs[0];
#pragma unroll
    for (int k = 0; k < 16; ++k) { cs[k] = __expf(cs[k] - c0); den += cs[k]; }
    const float inv = 1.f / den;
#pragma unroll
    for (int k = 0; k < 16; ++k) {
        const int a = cidx[k] >> 4, b2 = cidx[k] & 15; int i1 = 0, i2 = 0;
#pragma unroll
        for (int z = 0; z < 16; ++z) { if (z == a) i1 = ti0[z]; if (z == b2) i2 = ti1[z]; }
        idx[(size_t)t * 128 + h * 16 + k] = i1 * 128 + i2; gate[(size_t)t * 128 + h * 16 + k] = cs[k] * inv;
    }
}
__global__ void __launch_bounds__(256) k_peer_gather(float* xio, const float* ss2, const float* nfw, const bf16* ut, const bf16* vt, const int* idx, const float* gate,
                                                     const float* nplw_unused, bf16* x2b, float* r3) {
    const int t = blockIdx.x * 4 + (threadIdx.x >> 6), lane = threadIdx.x & 63;
    float* xr = xio + (size_t)t * D;
    const float r2 = rsqrtf(ss2[t] * (1.f / D) + RMS_EPS);
    float x1[16], hf[16];
#pragma unroll
    for (int j = 0; j < 2; ++j) { const f32x4 a = *(const f32x4*)(xr + j * 512 + lane * 8), b = *(const f32x4*)(xr + j * 512 + lane * 8 + 4);
        const f32x4 wa = *(const f32x4*)(nfw + j * 512 + lane * 8), wb = *(const f32x4*)(nfw + j * 512 + lane * 8 + 4);
        x1[j * 8 + 0] = a.x; x1[j * 8 + 1] = a.y; x1[j * 8 + 2] = a.z; x1[j * 8 + 3] = a.w; x1[j * 8 + 4] = b.x; x1[j * 8 + 5] = b.y; x1[j * 8 + 6] = b.z; x1[j * 8 + 7] = b.w;
        hf[j * 8 + 0] = a.x * r2 * wa.x; hf[j * 8 + 1] = a.y * r2 * wa.y; hf[j * 8 + 2] = a.z * r2 * wa.z; hf[j * 8 + 3] = a.w * r2 * wa.w;
        hf[j * 8 + 4] = b.x * r2 * wb.x; hf[j * 8 + 5] = b.y * r2 * wb.y; hf[j * 8 + 6] = b.z * r2 * wb.z; hf[j * 8 + 7] = b.w * r2 * wb.w; }
    float acc[16];
#pragma unroll
    for (int j = 0; j < 16; ++j) acc[j] = 0.f;
    for (int e = 0; e < 128; ++e) {
        const int id = idx[(size_t)t * 128 + e]; const float gt = gate[(size_t)t * 128 + e];
        const bf16* ur = ut + (size_t)id * D; const bf16* vr = vt + (size_t)id * D;
        float u0[8], u1[8]; unpack8(*(const v4u*)(ur + lane * 8), u0); unpack8(*(const v4u*)(ur + 512 + lane * 8), u1);
        float dsum = 0.f;
#pragma unroll
        for (int j = 0; j < 8; ++j) dsum += hf[j] * u0[j] + hf[8 + j] * u1[j];
        dsum = wave_sum(dsum);
        const float act = 0.5f * dsum * (1.f + erff(dsum * 0.70710678118654752f));
        const float wgt = gt * act;
        float v0[8], v1[8]; unpack8(*(const v4u*)(vr + lane * 8), v0); unpack8(*(const v4u*)(vr + 512 + lane * 8), v1);
#pragma unroll
        for (int j = 0; j < 8; ++j) { acc[j] += wgt * v0[j]; acc[8 + j] += wgt * v1[j]; }
    }
    float s = 0.f;
#pragma unroll
    for (int j = 0; j < 16; ++j) { acc[j] += x1[j]; s += acc[j] * acc[j]; }
    s = wave_sum(s);
    if (lane == 0) r3[t] = rsqrtf(s * (1.f / D) + RMS_EPS);
#pragma unroll
    for (int j = 0; j < 2; ++j) {
        *(f32x4*)(xr + j * 512 + lane * 8) = (f32x4){acc[j * 8 + 0], acc[j * 8 + 1], acc[j * 8 + 2], acc[j * 8 + 3]};
        *(f32x4*)(xr + j * 512 + lane * 8 + 4) = (f32x4){acc[j * 8 + 4], acc[j * 8 + 5], acc[j * 8 + 6], acc[j * 8 + 7]};
        v4u w; w.x = pk2(acc[j * 8 + 0], acc[j * 8 + 1]); w.y = pk2(acc[j * 8 + 2], acc[j * 8 + 3]); w.z = pk2(acc[j * 8 + 4], acc[j * 8 + 5]); w.w = pk2(acc[j * 8 + 6], acc[j * 8 + 7]);
        *(v4u*)(x2b + (size_t)t * D + j * 512 + lane * 8) = w;
    }
}
__global__ void __launch_bounds__(256) k_final(float* xio, const float* ss4, const float* fw) {
    const int row = blockIdx.x * 4 + (threadIdx.x >> 6), lane = threadIdx.x & 63;
    const float r = rsqrtf(ss4[row] * (1.f / D) + RMS_EPS);
    f32x4* xr = (f32x4*)(xio + (size_t)row * D) + lane; const f32x4* w = (const f32x4*)fw + lane;
#pragma unroll
    for (int j = 0; j < 4; ++j) { f32x4 v = xr[64 * j]; const f32x4 ww = w[64 * j]; v.x *= r * ww.x; v.y *= r * ww.y; v.z *= r * ww.z; v.w *= r * ww.w; xr[64 * j] = v; }
}

template <class Epi> static void gemm_simple(hipStream_t st, const bf16* A, const bf16* Bt, int M, int N, int K, const Epi& E) {
    hipLaunchKernelGGL(k_gemm_simple<Epi>, dim3(N / 64, M / 64), dim3(256), 0, st, A, Bt, M, N, K, E);
}

extern "C" void kernel_launch(void* const* d_in, const int* in_sizes, int n_in, void* d_out, int out_size, void* d_ws, size_t ws_size, hipStream_t stream) {
    if (n_in != 29 || ws_size < WS_END) { fprintf(stderr, "kernel_launch: unexpected n_in %d / ws %zu\n", n_in, ws_size); return; }
    const float* const* in = (const float* const*)d_in;
    unsigned char* ws = (unsigned char*)d_ws; unsigned char* dout = (unsigned char*)d_out;
    const float *x = in[0], *p = in[1], *norm_mix_w = in[2], *w_in = in[3], *hg_lb = in[4], *hg_norm_w = in[5], *rw_mu = in[6], *rw_w0 = in[7], *rw_w2 = in[8], *rw_a0 = in[9], *rw_a2 = in[10],
                *rw_g2 = in[11], *rw_k_k = in[12], *rw_k_a = in[13], *rw_r_k = in[14], *rw_ln_w = in[15], *rw_ln_b = in[16], *w_bh = in[17], *w_br = in[18], *w_out = in[19], *norm_ffn_w = in[20],
                *peer_wq = in[21], *peer_keys = in[22], *peer_u = in[23], *peer_v = in[24], *norm_ple_w = in[25], *ple_proj = in[26], *ple_gate = in[27], *final_norm_w = in[28];
    (void)hipMemsetAsync(ws + WS_CTL, 0, CTL_ZERO_BYTES, stream);
    float* SS2 = (float*)(ws + CTL_SS2); float* SS4 = (float*)(ws + CTL_SS4);
    float* R1 = (float*)(ws + SM_R1); float* R3 = (float*)(ws + SM_R3); float* LB = (float*)(ws + SM_LB); float* BONUS = (float*)(ws + SM_BONUS);
    bf16 *WIN = (bf16*)(ws + WS_WIN), *WBH = (bf16*)(ws + WS_WBH), *WBR = (bf16*)(ws + WS_WBR), *WOUT = (bf16*)(ws + WS_WOUT), *WQ = (bf16*)(ws + WS_WQ), *WPG = (bf16*)(ws + WS_WPG),
         *WPP = (bf16*)(ws + WS_WPP), *WLORA = (bf16*)(ws + WS_WLORA);
    bf16 *XB = (bf16*)(ws + WS_XB), *LW = (bf16*)(ws + WS_LW), *AA = (bf16*)(ws + WS_A), *YRW = (bf16*)(ws + WS_YRW), *PB = (bf16*)(ws + WS_PB);
    bf16 *CQ = (bf16*)(ws + WS_CQ), *M1 = (bf16*)(ws + WS_M1), *MERGED = (bf16*)(ws + WS_MERGED), *UT = (bf16*)(ws + WS_UT), *VT = (bf16*)(ws + WS_VT);
    bf16 *CRW = (bf16*)(ws + WS_CRW), *G = (bf16*)(ws + WS_G), *YRAW = (bf16*)(ws + WS_YRAW); int* IDX = (int*)(ws + WS_IDX); float* GATE = (float*)(ws + WS_GATE);
    bf16 *CG = (bf16*)(ws + WS_CG), *X1B = (bf16*)(ws + WS_X1B), *QP = (bf16*)(ws + WS_QP), *X2B = (bf16*)(ws + WS_X2B), *T2 = (bf16*)(ws + WS_T2);
    bf16 *RR = (bf16*)(dout + DO_R), *KK = (bf16*)(dout + DO_K), *VV = (bf16*)(dout + DO_V), *LIN = (bf16*)(dout + DO_LIN), *YHG = (bf16*)(dout + DO_YHG);
    float* XO = (float*)d_out;
    auto nb = [](size_t n) { return dim3((unsigned)((n + 255) / 256)); };

    hipLaunchKernelGGL(k_convT, nb((size_t)D * INC), dim3(256), 0, stream, w_in, norm_mix_w, D, INC, WIN, D, 0, 0);
    hipLaunchKernelGGL(k_convT, nb((size_t)512 * D), dim3(256), 0, stream, w_bh, (const float*)nullptr, 512, D, WBH, 512, 0, 0);
    hipLaunchKernelGGL(k_convT, nb((size_t)512 * D), dim3(256), 0, stream, w_br, (const float*)nullptr, 512, D, WBR, 512, 0, 0);
    hipLaunchKernelGGL(k_convT, nb((size_t)D * D), dim3(256), 0, stream, w_out, (const float*)nullptr, D, D, WOUT, D, 0, 0);
    hipLaunchKernelGGL(k_convT, nb((size_t)D * D), dim3(256), 0, stream, peer_wq, norm_ffn_w, D, D, WQ, D, 0, 0);
    hipLaunchKernelGGL(k_convT, nb((size_t)D * D), dim3(256), 0, stream, ple_gate, norm_ple_w, D, D, WPG, D, 0, 0);
    hipLaunchKernelGGL(k_convT, nb((size_t)PLE * D), dim3(256), 0, stream, ple_proj, (const float*)nullptr, PLE, D, WPP, PLE, 0, 0);
    hipLaunchKernelGGL(k_zero16, nb((size_t)1536 * 256), dim3(256), 0, stream, WLORA, (size_t)1536 * 256);
    hipLaunchKernelGGL(k_convT, nb((size_t)64 * 512), dim3(256), 0, stream, rw_w2, (const float*)nullptr, 64, 512, WLORA, 256, 0, 0);
    hipLaunchKernelGGL(k_convT, nb((size_t)64 * 512), dim3(256), 0, stream, rw_a2, (const float*)nullptr, 64, 512, WLORA, 256, 64, 512);
    hipLaunchKernelGGL(k_convT, nb((size_t)128 * 512), dim3(256), 0, stream, rw_g2, (const float*)nullptr, 128, 512, WLORA, 256, 128, 1024);
    hipLaunchKernelGGL(k_lb, dim3(2), dim3(256), 0, stream, hg_lb, LB);
    hipLaunchKernelGGL(k_xprep, dim3(T / 4), dim3(256), 0, stream, x, XB, R1);
    hipLaunchKernelGGL(k_conv, nb((size_t)T * PLE / 8), dim3(256), 0, stream, p, PB, (size_t)T * PLE / 8);
    gemm_simple(stream, XB, WIN, T, INC, D, EpiIn{R1, LB, CQ, CRW, CG});
    hipLaunchKernelGGL(k_rwshift, nb((size_t)T * RWC), dim3(256), 0, stream, CRW, rw_mu, RR, KK, VV, LIN);
    gemm_simple(stream, LIN, WLORA, T, 1536, 256, EpiLora{rw_w0, rw_a0, LW, AA, G});
    hipLaunchKernelGGL(k_hgrn_naive, dim3(BATCH * HGH), dim3(128), 0, stream, CQ, hg_norm_w, YHG);
    hipLaunchKernelGGL(k_rwkv_naive, dim3(BATCH * RWH), dim3(64), 0, stream, RR, KK, VV, LW, AA, rw_k_k, rw_k_a, rw_r_k, YRAW, BONUS);
    hipLaunchKernelGGL(k_rwpost, dim3(T * RWH / 4), dim3(256), 0, stream, YRAW, BONUS, VV, G, rw_ln_w, rw_ln_b, YRW);
    gemm_simple(stream, YHG, WBH, T, D, 512, EpiBranch1{CG, M1});
    gemm_simple(stream, YRW, WBR, T, D, 512, EpiBranch2{CG, M1, MERGED});
    gemm_simple(stream, MERGED, WOUT, T, D, D, EpiOut{x, XO, X1B, SS2});
    gemm_simple(stream, X1B, WQ, T, D, D, EpiQ{SS2, QP});
    hipLaunchKernelGGL(k_conv, nb((size_t)NEXP * D / 8), dim3(256), 0, stream, peer_u, UT, (size_t)NEXP * D / 8);
    hipLaunchKernelGGL(k_conv, nb((size_t)NEXP * D / 8), dim3(256), 0, stream, peer_v, VT, (size_t)NEXP * D / 8);
    hipLaunchKernelGGL(k_topk_naive, dim3(T / 4), dim3(32), 0, stream, QP, peer_keys, IDX, GATE);
    hipLaunchKernelGGL(k_peer_gather, dim3(T / 4), dim3(256), 0, stream, XO, SS2, norm_ffn_w, UT, VT, IDX, GATE, norm_ple_w, X2B, R3);
    gemm_simple(stream, PB, WPP, T, D, PLE, EpiPP{T2});
    gemm_simple(stream, X2B, WPG, T, D, D, EpiPG{R3, T2, XO, SS4});
    hipLaunchKernelGGL(k_final, dim3(T / 4), dim3(256), 0, stream, XO, SS4, final_norm_w);
}
```

```cpp
#include <hip/hip_runtime.h>
#include <cstdio>
#include <cstdint>
#include <utility>

constexpr int D = 1024, BATCH = 8, SEQ = 2048, T = BATCH * SEQ;
constexpr int INC = 5888;
constexpr int HGW = 512, HGH = 4, HGD = 128;
constexpr int RWW = 512, RWH = 8, RWD = 64, RWC = 1792;
constexpr int NEXP = 16384, NKEYS = 128, PKH = 8, PKTOP = 16, PKHALF = 64;
constexpr int PLE = 256;
constexpr float RMS_EPS = 1e-6f, GN_EPS = 64e-5f;

typedef unsigned short bf16;
typedef unsigned v4u __attribute__((ext_vector_type(4)));
typedef unsigned v2u __attribute__((ext_vector_type(2)));
typedef float f32x4 __attribute__((ext_vector_type(4)));
typedef float f32x2 __attribute__((ext_vector_type(2)));

constexpr size_t MiB = 1u << 20;
constexpr size_t WS_CTL = 0, CTL_ZERO_BYTES = 1 * MiB;
constexpr size_t CTL_SS2 = 256 * 1024, CTL_SS4 = 384 * 1024;
constexpr size_t WS_SMALL = 1 * MiB;
constexpr size_t SM_R1 = WS_SMALL, SM_R3 = WS_SMALL + 64 * 1024, SM_LB = WS_SMALL + 128 * 1024, SM_BONUS = WS_SMALL + 256 * 1024;
constexpr size_t WS_WIN = 2 * MiB;
constexpr size_t WS_WBH = 14 * MiB;
constexpr size_t WS_WBR = 15 * MiB;
constexpr size_t WS_WOUT = 16 * MiB;
constexpr size_t WS_WQ = 18 * MiB;
constexpr size_t WS_WPG = 20 * MiB;
constexpr size_t WS_WPP = 22 * MiB;
constexpr size_t WS_WLORA = 22 * MiB + 512 * 1024;
constexpr size_t WS_XB = 24 * MiB;
constexpr size_t WS_LW = WS_XB, WS_A = WS_XB + 16 * MiB, WS_YRW = WS_XB;
constexpr size_t WS_PB = 56 * MiB;
constexpr size_t WS_CQ = 64 * MiB;
constexpr size_t WS_M1 = WS_CQ, WS_MERGED = WS_CQ + 32 * MiB, WS_UT = WS_CQ, WS_VT = WS_CQ + 32 * MiB;
constexpr size_t WS_CRW = 128 * MiB;
constexpr size_t WS_G = WS_CRW, WS_HST = WS_CRW + 16 * MiB, WS_YRAW = WS_CRW + 36 * MiB, WS_IDX = WS_CRW, WS_GATE = WS_CRW + 8 * MiB;
constexpr size_t WS_CG = 184 * MiB;
constexpr size_t WS_X1B = WS_CG, WS_QP = WS_CG + 32 * MiB, WS_X2B = WS_CG, WS_T2 = WS_CG + 32 * MiB;
constexpr size_t WS_END = 256 * MiB;
constexpr size_t DO_R = 0, DO_K = 16 * MiB, DO_V = 32 * MiB, DO_LIN = 48 * MiB, DO_YHG = 48 * MiB;

__device__ __forceinline__ unsigned f2bf(float f) { unsigned u = __builtin_bit_cast(unsigned, f); return (u + 0x7fffu + ((u >> 16) & 1u)) >> 16; }
__device__ __forceinline__ unsigned pk2(float lo, float hi) { return f2bf(lo) | (f2bf(hi) << 16); }
__device__ __forceinline__ float bf2f(bf16 b) { return __builtin_bit_cast(float, ((unsigned)b) << 16); }
__device__ __forceinline__ float bflo(unsigned u) { return __builtin_bit_cast(float, u << 16); }
__device__ __forceinline__ float bfhi(unsigned u) { return __builtin_bit_cast(float, u & 0xffff0000u); }
__device__ __forceinline__ float sigmoidf_(float x) { return 1.f / (1.f + __expf(-x)); }
__device__ __forceinline__ float siluf_(float x) { return x / (1.f + __expf(-x)); }
__device__ __forceinline__ float wave_sum(float v) {
#pragma unroll
    for (int o = 1; o < 64; o <<= 1) v += __shfl_xor(v, o);
    return v;
}
__device__ __forceinline__ void unpack8(v4u w, float (&f)[8]) {
    f[0] = bflo(w.x); f[1] = bfhi(w.x); f[2] = bflo(w.y); f[3] = bfhi(w.y); f[4] = bflo(w.z); f[5] = bfhi(w.z); f[6] = bflo(w.w); f[7] = bfhi(w.w);
}
__device__ __forceinline__ v4u pack8(const float (&f)[8]) { v4u w; w.x = pk2(f[0], f[1]); w.y = pk2(f[2], f[3]); w.z = pk2(f[4], f[5]); w.w = pk2(f[6], f[7]); return w; }

struct EpiIn {
    const float* r1; const float* lb; bf16* cq; bf16* crw; bf16* cg;
    __device__ __forceinline__ void apply8(int row, int col0, float (&v)[8]) const {
        const float r = r1[row];
        float o[8];
        if (col0 < 512) {
#pragma unroll
            for (int j = 0; j < 8; ++j) o[j] = siluf_(v[j] * r) * 0.08838834764831845f;
            *(v4u*)(cq + (size_t)row * 2048 + col0) = pack8(o);
        } else if (col0 < 1024) {
#pragma unroll
            for (int j = 0; j < 8; ++j) { const float l = lb[col0 - 512 + j]; const float f = l + (1.f - l) * sigmoidf_(v[j] * r); o[j] = __logf(f); }
            *(v4u*)(cq + (size_t)row * 2048 + col0) = pack8(o);
        } else if (col0 < 1536) {
#pragma unroll
            for (int j = 0; j < 8; ++j) o[j] = v[j] * r;
            *(v4u*)(cq + (size_t)row * 2048 + col0) = pack8(o);
        } else if (col0 < 2048) {
#pragma unroll
            for (int j = 0; j < 8; ++j) o[j] = siluf_(v[j] * r);
            *(v4u*)(cq + (size_t)row * 2048 + col0) = pack8(o);
        } else if (col0 < 3840) {
#pragma unroll
            for (int j = 0; j < 8; ++j) o[j] = v[j] * r;
            *(v4u*)(crw + (size_t)row * RWC + (col0 - 2048)) = pack8(o);
        } else {
#pragma unroll
            for (int j = 0; j < 8; ++j) o[j] = sigmoidf_(v[j] * r);
            *(v4u*)(cg + (size_t)row * 2048 + (col0 - 3840)) = pack8(o);
        }
    }
};
struct EpiLora {
    const float* w0; const float* a0; bf16* lw; bf16* a; bf16* g;
    __device__ __forceinline__ void apply8(int row, int col0, float (&v)[8]) const {
        float o[8];
        if (col0 < 512) {
#pragma unroll
            for (int j = 0; j < 8; ++j) { const float z = -(w0[col0 + j] + v[j]); const float sp = fmaxf(z, 0.f) + log1pf(__expf(-fabsf(z))); o[j] = -__expf(-sp - 0.5f); }
            *(v4u*)(lw + (size_t)row * 512 + col0) = pack8(o);
        } else if (col0 < 1024) {
#pragma unroll
            for (int j = 0; j < 8; ++j) o[j] = sigmoidf_(a0[col0 - 512 + j] + v[j]);
            *(v4u*)(a + (size_t)row * 512 + col0 - 512) = pack8(o);
        } else {
            *(v4u*)(g + (size_t)row * 512 + col0 - 1024) = pack8(v);
        }
    }
};
struct EpiBranch1 {
    const bf16* cg; bf16* m1;
    __device__ __forceinline__ void apply8(int row, int col0, float (&v)[8]) const {
        float gt[8]; unpack8(*(const v4u*)(cg + (size_t)row * 2048 + col0), gt);
        float o[8];
#pragma unroll
        for (int j = 0; j < 8; ++j) o[j] = gt[j] * v[j];
        *(v4u*)(m1 + (size_t)row * 1024 + col0) = pack8(o);
    }
};
struct EpiBranch2 {
    const bf16* cg; const bf16* m1; bf16* mg;
    __device__ __forceinline__ void apply8(int row, int col0, float (&v)[8]) const {
        float gt[8], p[8]; unpack8(*(const v4u*)(cg + (size_t)row * 2048 + 1024 + col0), gt); unpack8(*(const v4u*)(m1 + (size_t)row * 1024 + col0), p);
        float o[8];
#pragma unroll
        for (int j = 0; j < 8; ++j) o[j] = p[j] + gt[j] * v[j];
        *(v4u*)(mg + (size_t)row * 1024 + col0) = pack8(o);
    }
};
struct EpiOut {
    const float* x; float* x1; bf16* x1b; float* ss2;
    __device__ __forceinline__ void apply8(int row, int col0, float (&v)[8]) const {
        const f32x4 a = *(const f32x4*)(x + (size_t)row * D + col0), b = *(const f32x4*)(x + (size_t)row * D + col0 + 4);
        float o[8] = {a.x + v[0], a.y + v[1], a.z + v[2], a.w + v[3], b.x + v[4], b.y + v[5], b.z + v[6], b.w + v[7]};
        *(f32x4*)(x1 + (size_t)row * D + col0) = (f32x4){o[0], o[1], o[2], o[3]};
        *(f32x4*)(x1 + (size_t)row * D + col0 + 4) = (f32x4){o[4], o[5], o[6], o[7]};
        *(v4u*)(x1b + (size_t)row * D + col0) = pack8(o);
        float s = 0.f;
#pragma unroll
        for (int j = 0; j < 8; ++j) s += o[j] * o[j];
        atomicAdd(ss2 + row, s);
    }
};
struct EpiQ {
    const float* ss2; bf16* qp;
    __device__ __forceinline__ void apply8(int row, int col0, float (&v)[8]) const {
        const float r = rsqrtf(ss2[row] * (1.f / D) + RMS_EPS);
        float o[8];
#pragma unroll
        for (int j = 0; j < 8; ++j) o[j] = v[j] * r;
        *(v4u*)(qp + (size_t)row * D + col0) = pack8(o);
    }
};
struct EpiPP {
    bf16* t2;
    __device__ __forceinline__ void apply8(int row, int col0, float (&v)[8]) const { *(v4u*)(t2 + (size_t)row * D + col0) = pack8(v); }
};
struct EpiPG {
    const float* r3; const bf16* t2; float* xio; float* ss4;
    __device__ __forceinline__ void apply8(int row, int col0, float (&v)[8]) const {
        const float r = r3[row];
        float t[8]; unpack8(*(const v4u*)(t2 + (size_t)row * D + col0), t);
        const f32x4 a = *(const f32x4*)(xio + (size_t)row * D + col0), b = *(const f32x4*)(xio + (size_t)row * D + col0 + 4);
        float xin[8] = {a.x, a.y, a.z, a.w, b.x, b.y, b.z, b.w}, o[8]; float s = 0.f;
#pragma unroll
        for (int j = 0; j < 8; ++j) { o[j] = xin[j] + sigmoidf_(v[j] * r) * t[j]; s += o[j] * o[j]; }
        *(f32x4*)(xio + (size_t)row * D + col0) = (f32x4){o[0], o[1], o[2], o[3]};
        *(f32x4*)(xio + (size_t)row * D + col0 + 4) = (f32x4){o[4], o[5], o[6], o[7]};
        atomicAdd(ss4 + row, s);
    }
};


namespace pg8 {
#define PG8_LAS __attribute__((address_space(3)))
typedef unsigned short bf16_t;
typedef short bf16x8 __attribute__((ext_vector_type(8)));
typedef float f32x4 __attribute__((ext_vector_type(4)));
typedef unsigned u32x4 __attribute__((ext_vector_type(4)));
constexpr int BM = 256, BK = 64, HALF = 128, HTB = HALF * BK * 2  , STAGE_BYTES = 8 * HTB, NXCD = 8, WGM = 8;

__host__ __device__ __forceinline__ int lds_byte(int r, int c) { const int st = (r >> 4) * 2 + (c >> 5), rr = r & 15, cc = c & 31, ob = rr * 64 + cc * 2; return st * 1024 + (ob ^ (((ob >> 9) & 1) << 5)); }
__host__ __device__ __forceinline__ void stage_rc(int b, int& R, int& C) { const int st = b / 1024, sb = b % 1024, swz = sb ^ (((sb >> 9) & 1) << 5); R = (st >> 1) * 16 + swz / 64; C = (st & 1) * 32 + (swz % 64) / 2; }
__host__ __device__ __forceinline__ int perm32(int rho) { const int n = rho >> 4, i = rho & 15; return 8 * (i >> 2) + 4 * n + (i & 3); }

struct Unit { int pm, pn; };
struct Gemm { const bf16_t* A; const bf16_t* Bt; int M, N, K; };

struct StaticOrder {
    int nM, nN, nwg, G, c;
    __host__ __device__ void init(int M, int N, int G_, int c_) { nM = M / BM; nN = N / BM; nwg = nM * nN; G = G_; c = c_; }
    __host__ __device__ bool next(int i, Unit& u) const {
        const long L = (long)i * G + c; if (L >= nwg) return false;
        int wgid = (int)L; { const int q = nwg / NXCD, r = nwg % NXCD, xcd = wgid % NXCD, off = wgid / NXCD; wgid = (xcd < r ? xcd * (q + 1) : r * (q + 1) + (xcd - r) * q) + off; }
        const int nig = WGM * nN, gid = wgid / nig, fm = gid * WGM, gsz = (nM - fm) < WGM ? (nM - fm) : WGM;
        u.pm = fm + ((wgid % nig) % gsz); u.pn = (wgid % nig) / gsz; return true;
    }
    __device__ __forceinline__ void a_ready(const Unit&) const {}
    __device__ __forceinline__ void done(const Unit&) const {}
};

template <class Epi, class Sched, bool ALIGN_EPI = false, bool SP2 = false>
__device__ __forceinline__ void gemm_phase(PG8_LAS unsigned char* lds, const Gemm g, const Sched& S, const Epi& E) {
    const int tid = threadIdx.x, wid = __builtin_amdgcn_readfirstlane(tid >> 6), lane = tid & 63, wr = wid >> 2, wc = wid & 3, fr = lane & 15, fq = lane >> 4;
    const int K = g.K, nt = K / BK;
    unsigned voffA[2], voffB[2];
#pragma unroll
    for (int i = 0; i < 2; ++i) { int R, C; stage_rc(tid * 16 + i * 8192, R, C); const int Rb = Epi::PERM ? ((R & ~31) + perm32(R & 31)) : R;
        voffA[i] = (unsigned)(R * K + C) * 2u; voffB[i] = (unsigned)(Rb * K + C) * 2u; }
    const size_t kstep = (size_t)(BK * 2);
    const size_t hstep = (size_t)HALF * K * 2;
    const size_t tstep = 2 * hstep;
    const unsigned ldsw = (unsigned)wid * 1024u;
    const int aoff = lds_byte(wr * 64 + fr, fq * 8), boff = lds_byte(wc * 32 + fr, fq * 8);
#define PG8_SA(b, h) (((b) * 2 + (h)) * HTB)
#define PG8_SB(b, h) ((4 + (b) * 2 + (h)) * HTB)
#define PG8_STAGE(bufoff, gbase, voff) do { _Pragma("unroll") for (int _i = 0; _i < 2; ++_i) \
        __builtin_amdgcn_global_load_lds((const unsigned*)((const char*)(gbase) + (voff)[_i]), (PG8_LAS unsigned*)(lds + (bufoff) + ldsw + _i * 8192), 16, 0, 0); } while (0)
#define PG8_LDA(dst, b, h) do { _Pragma("unroll") for (int m = 0; m < 4; ++m) _Pragma("unroll") for (int k = 0; k < 2; ++k) dst[m][k] = *(const PG8_LAS bf16x8*)(lds + PG8_SA(b, h) + aoff + m * 2048 + k * 1024); } while (0)
#define PG8_LDB(dst, b, h) do { _Pragma("unroll") for (int n = 0; n < 2; ++n) _Pragma("unroll") for (int k = 0; k < 2; ++k) dst[n][k] = *(const PG8_LAS bf16x8*)(lds + PG8_SB(b, h) + boff + n * 2048 + k * 1024); } while (0)
#define PG8_MMA(ai, bj, At, Bt) do { __builtin_amdgcn_s_setprio(1); _Pragma("unroll") for (int m = 0; m < 4; ++m) _Pragma("unroll") for (int n = 0; n < 2; ++n) _Pragma("unroll") for (int k = 0; k < 2; ++k) \
        acc[ai][bj][m][n] = __builtin_amdgcn_mfma_f32_16x16x32_bf16(Bt[n][k], At[m][k], acc[ai][bj][m][n], 0, 0, 0); __builtin_amdgcn_s_setprio(0); } while (0)
#define PG8_WAIT_V(n) asm volatile("s_waitcnt vmcnt(" #n ")" ::: "memory")
#define PG8_WAIT_L(n) asm volatile("s_waitcnt lgkmcnt(" #n ")" ::: "memory")
#define PG8_BAR __builtin_amdgcn_s_barrier()
#define PG8_SCHED __builtin_amdgcn_sched_barrier(0)
    Unit cur, nxt; int ui = 0;
    if (!S.next(0, cur)) return;
    f32x4 acc[2][2][4][2];
#pragma unroll
    for (int a = 0; a < 2; ++a)
#pragma unroll
        for (int b = 0; b < 2; ++b)
#pragma unroll
            for (int m = 0; m < 4; ++m)
#pragma unroll
                for (int n = 0; n < 2; ++n) acc[a][b][m][n] = (f32x4){0.f, 0.f, 0.f, 0.f};
    bf16x8 At[4][2], B0[2][2], B1[2][2];
    const char* cA = (const char*)g.A + (size_t)cur.pm * tstep; const char* cB = (const char*)g.Bt + (size_t)cur.pn * tstep;
    S.a_ready(cur);
    if constexpr (SP2) {
        PG8_STAGE(PG8_SB(0, 0), cB, voffB); PG8_STAGE(PG8_SB(0, 1), cB + hstep, voffB); PG8_STAGE(PG8_SA(0, 0), cA, voffA); PG8_STAGE(PG8_SA(0, 1), cA + hstep, voffA);
        if (wr == 1) PG8_BAR;
        PG8_WAIT_V(2); PG8_BAR;
        PG8_STAGE(PG8_SB(1, 0), cB + kstep, voffB); PG8_STAGE(PG8_SA(1, 0), cA + kstep, voffA); PG8_STAGE(PG8_SB(1, 1), cB + hstep + kstep, voffB);
        PG8_WAIT_V(6); PG8_BAR;
    } else {
        PG8_STAGE(PG8_SB(0, 0), cB, voffB); PG8_STAGE(PG8_SA(0, 0), cA, voffA); PG8_STAGE(PG8_SB(0, 1), cB + hstep, voffB); PG8_STAGE(PG8_SA(0, 1), cA + hstep, voffA);
        if (wr == 1) PG8_BAR;
        PG8_WAIT_V(4); PG8_BAR;
        PG8_STAGE(PG8_SB(1, 0), cB + kstep, voffB); PG8_STAGE(PG8_SA(1, 0), cA + kstep, voffA); PG8_STAGE(PG8_SB(1, 1), cB + hstep + kstep, voffB);
        PG8_WAIT_V(6); PG8_BAR;
    }
    for (;;) {
        const bool has_next = S.next(ui + 1, nxt);
        const char* nA = has_next ? (const char*)g.A + (size_t)nxt.pm * tstep : cA; const char* nB = has_next ? (const char*)g.Bt + (size_t)nxt.pn * tstep : cB;
#pragma unroll 1
        for (int t = 0; t < nt; t += 2) {
            const bool last = (t == nt - 2);
            const char* a1 = cA + (size_t)(t + 1) * kstep;
            const char* a2 = last ? nA : cA + (size_t)(t + 2) * kstep; const char* b2 = last ? nB : cB + (size_t)(t + 2) * kstep;
            const char* a3 = a2 + kstep; const char* b3 = b2 + kstep;
            if (last && has_next) S.a_ready(nxt);
            if constexpr (SP2) {
            PG8_LDB(B0, 0, 0); PG8_LDB(B1, 0, 1); PG8_SCHED; PG8_LDA(At, 0, 0); PG8_STAGE(PG8_SA(1, 1), a1 + hstep, voffA);
            PG8_WAIT_V(8); PG8_WAIT_L(0); PG8_BAR; PG8_MMA(0, 0, At, B0); PG8_MMA(0, 1, At, B1); PG8_BAR; PG8_SCHED;
            PG8_LDA(At, 0, 1); PG8_STAGE(PG8_SB(0, 0), b2, voffB); PG8_STAGE(PG8_SB(0, 1), b2 + hstep, voffB); PG8_STAGE(PG8_SA(0, 0), a2, voffA);
            PG8_WAIT_V(8); PG8_WAIT_L(0); PG8_BAR; PG8_MMA(1, 0, At, B0); PG8_MMA(1, 1, At, B1); PG8_BAR; PG8_SCHED;
            PG8_LDB(B0, 1, 0); PG8_LDB(B1, 1, 1); PG8_SCHED; PG8_LDA(At, 1, 0); PG8_STAGE(PG8_SA(0, 1), a2 + hstep, voffA);
            PG8_WAIT_V(8); PG8_WAIT_L(0); PG8_BAR; PG8_MMA(0, 0, At, B0); PG8_MMA(0, 1, At, B1); PG8_BAR; PG8_SCHED;
            PG8_LDA(At, 1, 1); PG8_STAGE(PG8_SB(1, 0), b3, voffB); PG8_STAGE(PG8_SB(1, 1), b3 + hstep, voffB); PG8_STAGE(PG8_SA(1, 0), a3, voffA);
            PG8_WAIT_V(8); PG8_WAIT_L(0); PG8_BAR; PG8_MMA(1, 0, At, B0); PG8_MMA(1, 1, At, B1); PG8_BAR; PG8_SCHED;
            } else {
            PG8_LDB(B0, 0, 0); PG8_SCHED; PG8_LDA(At, 0, 0); PG8_STAGE(PG8_SA(1, 1), a1 + hstep, voffA);
            PG8_WAIT_L(8); PG8_BAR; PG8_WAIT_L(0); PG8_MMA(0, 0, At, B0); PG8_BAR; PG8_SCHED;
            PG8_LDB(B1, 0, 1); PG8_STAGE(PG8_SB(0, 0), b2, voffB);
            PG8_BAR; PG8_WAIT_L(0); PG8_MMA(0, 1, At, B1); PG8_BAR;
            PG8_LDA(At, 0, 1); PG8_STAGE(PG8_SA(0, 0), a2, voffA);
            PG8_BAR; PG8_WAIT_L(0); PG8_MMA(1, 0, At, B0); PG8_BAR; PG8_SCHED;
            PG8_STAGE(PG8_SB(0, 1), b2 + hstep, voffB);
            PG8_WAIT_V(6); PG8_BAR; PG8_MMA(1, 1, At, B1); PG8_BAR;
            PG8_LDB(B0, 1, 0); PG8_SCHED; PG8_LDA(At, 1, 0); PG8_STAGE(PG8_SA(0, 1), a2 + hstep, voffA);
            PG8_WAIT_L(8); PG8_BAR; PG8_WAIT_L(0); PG8_MMA(0, 0, At, B0); PG8_BAR; PG8_SCHED;
            PG8_LDB(B1, 1, 1); PG8_STAGE(PG8_SB(1, 0), b3, voffB);
            PG8_BAR; PG8_WAIT_L(0); PG8_MMA(0, 1, At, B1); PG8_BAR;
            PG8_LDA(At, 1, 1); PG8_STAGE(PG8_SA(1, 0), a3, voffA);
            PG8_BAR; PG8_WAIT_L(0); PG8_MMA(1, 0, At, B0); PG8_BAR; PG8_SCHED;
            PG8_STAGE(PG8_SB(1, 1), b3 + hstep, voffB);
            PG8_WAIT_V(6); PG8_BAR; PG8_MMA(1, 1, At, B1); PG8_BAR;
            }
        }
        if constexpr (ALIGN_EPI) { if (wr == 0) PG8_BAR; }
        if constexpr (!Epi::AFTER_DRAIN) { E(acc, cur, wr, wc, fr, fq); S.done(cur); }
        if (!has_next) break;
#pragma unroll
        for (int a = 0; a < 2; ++a)
#pragma unroll
            for (int b = 0; b < 2; ++b)
#pragma unroll
                for (int m = 0; m < 4; ++m)
#pragma unroll
                    for (int n = 0; n < 2; ++n) acc[a][b][m][n] = (f32x4){0.f, 0.f, 0.f, 0.f};
        cur = nxt; cA = nA; cB = nB; ++ui;
        if constexpr (ALIGN_EPI) { if (wr == 1) PG8_BAR; }
    }
    PG8_WAIT_V(0);
    if constexpr (!ALIGN_EPI) { if (wr == 0) PG8_BAR; }
    PG8_BAR;
    if constexpr (Epi::AFTER_DRAIN) { E.fused(acc, cur, wr, wc, fr, fq, lds, wid, lane); S.done(cur); }
#undef PG8_SA
#undef PG8_SB
#undef PG8_STAGE
#undef PG8_LDA
#undef PG8_LDB
#undef PG8_MMA
#undef PG8_WAIT_V
#undef PG8_WAIT_L
#undef PG8_BAR
#undef PG8_SCHED
}
}


template <class E> struct EpiAdapt {
    static constexpr bool PERM = true, AFTER_DRAIN = false;
    E e;
    template <int I> __device__ __forceinline__ void one(const pg8::f32x4 (&acc)[2][2][4][2], int rowb, int colb) const {
        constexpr int ai = I / 8, m = (I / 2) % 4, bj = I % 2;
        const pg8::f32x4 a0 = acc[ai][bj][m][0], a1 = acc[ai][bj][m][1];
        float v[8] = {a0[0], a0[1], a0[2], a0[3], a1[0], a1[1], a1[2], a1[3]};
        e.apply8(rowb + ai * 128 + m * 16, colb + bj * 128, v);
        asm volatile("" ::: "memory");
    }
    template <int... I> __device__ __forceinline__ void all(std::integer_sequence<int, I...>, const pg8::f32x4 (&acc)[2][2][4][2], int rowb, int colb) const { (one<I>(acc, rowb, colb), ...); }
    __device__ __forceinline__ void operator()(const pg8::f32x4 (&acc)[2][2][4][2], const pg8::Unit& u, int wr, int wc, int fr, int fq) const {
        all(std::make_integer_sequence<int, 16>{}, acc, u.pm * 256 + wr * 64 + fr, u.pn * 256 + wc * 32 + 8 * fq);
    }
};

constexpr int NWAVES = 8, NTHR = 512;
constexpr int RING_OFF = 0, RING_BYTES = 131072;
constexpr int LDSCTL_OFF = RING_BYTES, MISC_OFF = LDSCTL_OFF + 320;
constexpr int LDS_BYTES = 147456;
constexpr int CW_BAR = 4096;
#define LAS __attribute__((address_space(3)))
#define LDS_WAIT() asm volatile("s_waitcnt lgkmcnt(0)" ::: "memory")
#define VM_WAIT() asm volatile("s_waitcnt vmcnt(0)" ::: "memory")

#define XB_TMO      128
#define XB_XCNT(j)  (256  + 64 * (j))
#define XB_XSUB(j)  (1280 + 64 * (j))
#define XB_XGEN(j)  (2304 + 64 * (j))
#define XB_TOP      3328
#define XB_TOPGEN   3392
#define XCD_BAR_WORDS 3456
#define XB_SPIN_CAP (1u << 18)

__device__ __forceinline__ unsigned xb_ld(unsigned* p)              { return __hip_atomic_load(p, __ATOMIC_RELAXED, __HIP_MEMORY_SCOPE_AGENT); }
__device__ __forceinline__ unsigned xb_add(unsigned* p, unsigned v) { return __hip_atomic_fetch_add(p, v, __ATOMIC_RELAXED, __HIP_MEMORY_SCOPE_AGENT); }
__device__ __forceinline__ unsigned xb_xcc_id() { return (unsigned)__builtin_amdgcn_s_getreg((3 << 11) | 20) & 0xFu; }
#define XB_SPIN(cond, bar) do { unsigned _sp = 0; while (cond) { __builtin_amdgcn_s_sleep(1); \
    if ((++_sp & 255u) == 0u) { if (xb_ld(&(bar)[XB_TMO])) break; if (_sp > XB_SPIN_CAP) { atomicAdd(&(bar)[XB_TMO], 1u); break; } } } } while (0)

struct XcdBarrier {
    unsigned* bar; unsigned x;
    volatile LAS unsigned* st;
};

__device__ __forceinline__ XcdBarrier xcd_barrier_post(unsigned* bar, volatile LAS unsigned* st) {
    XcdBarrier b; b.bar = bar; b.x = xb_xcc_id(); b.st = st;
    if (threadIdx.x == 0) (void)xb_add(&bar[XB_XCNT(b.x)], 1u);
    return b;
}
__device__ __forceinline__ void xcd_barrier_complete(unsigned* bar, unsigned x, unsigned& nloc, unsigned& nx) {
    const unsigned G = gridDim.x * gridDim.y * gridDim.z;
    unsigned sum, cnt, mine, sp = 0u;
    for (;;) {
        sum = 0u; cnt = 0u; mine = 0u;
#pragma unroll
        for (unsigned j = 0; j < 16; ++j) { const unsigned c = xb_ld(&bar[XB_XCNT(j)]); sum += c; cnt += (c > 0u) ? 1u : 0u; mine = (j == x) ? c : mine; }
        if (sum == G) break;
        __builtin_amdgcn_s_sleep(1);
        if ((++sp & 255u) == 0u) { if (xb_ld(&bar[XB_TMO])) break; if (sp > XB_SPIN_CAP) { atomicAdd(&bar[XB_TMO], 1u); break; } }
    }
    nloc = mine > 0u ? mine : 1u; nx = cnt > 0u ? cnt : 1u;
}

__device__ __forceinline__ void xcd_barrier(const XcdBarrier& b) {
    asm volatile("s_waitcnt vmcnt(0)" ::: "memory");
    __syncthreads();
    if (threadIdx.x == 0) {
        unsigned* bar = b.bar;
        __builtin_amdgcn_s_waitcnt(0);
        unsigned nloc = b.st[0], nx = b.st[1];
        if (nloc == 0u) { xcd_barrier_complete(bar, b.x, nloc, nx); b.st[0] = nloc; b.st[1] = nx; }
        const unsigned old = xb_add(&bar[XB_XSUB(b.x)], 1u);
        const unsigned gen = old / nloc;
        if (old + 1u == (gen + 1u) * nloc) {
            __builtin_amdgcn_fence(__ATOMIC_RELEASE, "agent");
            asm volatile("s_waitcnt vmcnt(0)" ::: "memory");
            const unsigned og = xb_add(&bar[XB_TOP], 1u);
            const unsigned tg = og / nx;
            if (og + 1u == (tg + 1u) * nx) xb_add(&bar[XB_TOPGEN], 1u);
            else XB_SPIN(xb_ld(&bar[XB_TOPGEN]) == tg, bar);
            __builtin_amdgcn_fence(__ATOMIC_ACQUIRE, "agent");
            xb_add(&bar[XB_XGEN(b.x)], 1u);
            asm volatile("s_waitcnt vmcnt(0)" ::: "memory");
        } else {
            XB_SPIN(xb_ld(&bar[XB_XGEN(b.x)]) == gen, bar);
            __builtin_amdgcn_fence(__ATOMIC_ACQUIRE, "agent");
            asm volatile("s_waitcnt vmcnt(0)" ::: "memory");
        }
    }
    __syncthreads();
}


static_assert((CW_BAR + 8 * XCD_BAR_WORDS) * 4 <= (int)CTL_SS2, "barrier regions below the accumulators");

enum Phase { PH_PRO = 0, PH_GEMM1, PH_RWSHIFT, PH_LORA, PH_HGRN, PH_RWKV, PH_RWPOST, PH_BR, PH_OUT, PH_QG, PH_TOPK, PH_GATHER, PH_PLE, PH_FINAL, PH_N };

struct Args { const float* in[29]; float* out; unsigned char* ws; int ph_lo, ph_hi, li, pad; };

struct Frame {
    LAS unsigned char* lds;
    int tid, lane, wave, vcu, G;
};

__device__ __forceinline__ void tr_item(const float* W, const float* sk, int K, int N, bf16* WT, int ldk, int koff, int row_off, LAS float* scr, int item, int lane) {
    const int nblk = N / 32, kb = item / nblk, nb = item % nblk, k0 = 64 * kb, n0 = 32 * nb;
#pragma unroll 8
    for (int i = 0; i < 32; ++i) { const int kk = 2 * i + (lane >> 5); float v = W[(size_t)(k0 + kk) * N + n0 + (lane & 31)]; if (sk) v *= sk[k0 + kk]; scr[kk * 33 + (lane & 31)] = v; }
    LDS_WAIT(); asm volatile("" ::: "memory");
    const int c = lane & 7;
#pragma unroll
    for (int j = 0; j < 4; ++j) { const int n = (lane >> 3) + 8 * j; const LAS float* s = scr + (8 * c) * 33 + n;
        v4u o; o.x = pk2(s[0 * 33], s[1 * 33]); o.y = pk2(s[2 * 33], s[3 * 33]); o.z = pk2(s[4 * 33], s[5 * 33]); o.w = pk2(s[6 * 33], s[7 * 33]);
        *(v4u*)(WT + (size_t)(row_off + n0 + n) * ldk + koff + k0 + 8 * c) = o; }
    LDS_WAIT(); asm volatile("" ::: "memory");
}

__device__ __forceinline__ void xprep_row(const float* x, bf16* xb, float* r1, int row, int lane) {
    const f32x4* xr = (const f32x4*)(x + (size_t)row * D) + lane;
    f32x4 v[4]; float s = 0.f;
#pragma unroll
    for (int j = 0; j < 4; ++j) { v[j] = xr[64 * j]; s += (v[j].x * v[j].x + v[j].y * v[j].y) + (v[j].z * v[j].z + v[j].w * v[j].w); }
    s = wave_sum(s);
    if (lane == 0) r1[row] = rsqrtf(s * (1.f / D) + RMS_EPS);
    v2u* o = (v2u*)(xb + (size_t)row * D) + lane;
#pragma unroll
    for (int j = 0; j < 4; ++j) { v2u w; w.x = pk2(v[j].x, v[j].y); w.y = pk2(v[j].z, v[j].w); o[64 * j] = w; }
}

__device__ __forceinline__ void peer_token(float* xr, float ss2t, const float* nfw, const bf16* ut, const bf16* vt, const int* idx, const float* gate, bf16* x2b_row, float* r3t, int lane) {
    const float r2 = rsqrtf(ss2t * (1.f / D) + RMS_EPS);
    float x1[16], hf[16];
#pragma unroll
    for (int j = 0; j < 2; ++j) { const f32x4 a = *(const f32x4*)(xr + j * 512 + lane * 8), b = *(const f32x4*)(xr + j * 512 + lane * 8 + 4);
        const f32x4 wa = *(const f32x4*)(nfw + j * 512 + lane * 8), wb = *(const f32x4*)(nfw + j * 512 + lane * 8 + 4);
        x1[j * 8 + 0] = a.x; x1[j * 8 + 1] = a.y; x1[j * 8 + 2] = a.z; x1[j * 8 + 3] = a.w; x1[j * 8 + 4] = b.x; x1[j * 8 + 5] = b.y; x1[j * 8 + 6] = b.z; x1[j * 8 + 7] = b.w;
        hf[j * 8 + 0] = a.x * r2 * wa.x; hf[j * 8 + 1] = a.y * r2 * wa.y; hf[j * 8 + 2] = a.z * r2 * wa.z; hf[j * 8 + 3] = a.w * r2 * wa.w;
        hf[j * 8 + 4] = b.x * r2 * wb.x; hf[j * 8 + 5] = b.y * r2 * wb.y; hf[j * 8 + 6] = b.z * r2 * wb.z; hf[j * 8 + 7] = b.w * r2 * wb.w; }
    float acc[16];
#pragma unroll
    for (int j = 0; j < 16; ++j) acc[j] = 0.f;
    for (int e = 0; e < 128; ++e) {
        const int id = idx[e]; const float gt = gate[e];
        const bf16* ur = ut + (size_t)id * D; const bf16* vr = vt + (size_t)id * D;
        float u0[8], u1[8]; unpack8(*(const v4u*)(ur + lane * 8), u0); unpack8(*(const v4u*)(ur + 512 + lane * 8), u1);
        float dsum = 0.f;
#pragma unroll
        for (int j = 0; j < 8; ++j) dsum += hf[j] * u0[j] + hf[8 + j] * u1[j];
        dsum = wave_sum(dsum);
        const float act = 0.5f * dsum * (1.f + erff(dsum * 0.70710678118654752f));
        const float wgt = gt * act;
        float v0[8], v1[8]; unpack8(*(const v4u*)(vr + lane * 8), v0); unpack8(*(const v4u*)(vr + 512 + lane * 8), v1);
#pragma unroll
        for (int j = 0; j < 8; ++j) { acc[j] += wgt * v0[j]; acc[8 + j] += wgt * v1[j]; }
    }
    float s = 0.f;
#pragma unroll
    for (int j = 0; j < 16; ++j) { acc[j] += x1[j]; s += acc[j] * acc[j]; }
    s = wave_sum(s);
    if (lane == 0) *r3t = rsqrtf(s * (1.f / D) + RMS_EPS);
#pragma unroll
    for (int j = 0; j < 2; ++j) {
        *(f32x4*)(xr + j * 512 + lane * 8) = (f32x4){acc[j * 8 + 0], acc[j * 8 + 1], acc[j * 8 + 2], acc[j * 8 + 3]};
        *(f32x4*)(xr + j * 512 + lane * 8 + 4) = (f32x4){acc[j * 8 + 4], acc[j * 8 + 5], acc[j * 8 + 6], acc[j * 8 + 7]};
        v4u w; w.x = pk2(acc[j * 8 + 0], acc[j * 8 + 1]); w.y = pk2(acc[j * 8 + 2], acc[j * 8 + 3]); w.z = pk2(acc[j * 8 + 4], acc[j * 8 + 5]); w.w = pk2(acc[j * 8 + 6], acc[j * 8 + 7]);
        *(v4u*)(x2b_row + j * 512 + lane * 8) = w;
    }
}


template <int CTRL> __device__ __forceinline__ float dppf(float x) { return __builtin_bit_cast(float, __builtin_amdgcn_update_dpp(0, __builtin_bit_cast(int, x), CTRL, 0xf, 0xf, true)); }
__device__ __forceinline__ float red8(float x) { x += dppf<0xB1>(x); x += dppf<0x4E>(x); x += dppf<0x141>(x); return x; }
__device__ __forceinline__ float red16(float x) { x = red8(x); x += dppf<0x140>(x); return x; }
__device__ __forceinline__ float red32(float x) {
    x = red16(x);
    float a = x, b = x;
    asm volatile("s_nop 1\n\tv_permlane16_swap_b32 %0, %1\n\ts_nop 1" : "+v"(a), "+v"(b));
    return a + b;
}

constexpr int RW_CH = 64;
constexpr int RW_REC = 6 * 64;
__device__ __forceinline__ void rwkv_item(Frame& F, int item, const bf16* R, const bf16* Kk, const bf16* V, const bf16* LW, const bf16* A, const float* k_k, const float* k_a, const float* r_k,
                                          bf16* yraw, float* bonus) {
    LAS float* REC = (LAS float*)(F.lds + RING_OFF);
    LAS float* YS = REC + RW_CH * RW_REC;
    const int pair = item >> 2, rq = item & 3, b = pair / RWH, h = pair % RWH;
    const int tid = F.tid, tk = tid >> 3, c8 = (tid & 7) * 8;
    const int row = tid >> 5, kp = tid & 31;
    float ckk[8], cka[8], crk[8];
#pragma unroll
    for (int j = 0; j < 8; ++j) { ckk[j] = k_k[h * 64 + c8 + j]; cka[j] = k_a[h * 64 + c8 + j]; crk[j] = r_k[h * 64 + c8 + j]; }
    float S0 = 0.f, S1 = 0.f;
    const size_t gbase = ((size_t)b * SEQ + tk) * 512 + h * 64 + c8;
    v4u rr, rk, rv, ra, rl;
    rr = *(const v4u*)(R + gbase); rk = *(const v4u*)(Kk + gbase); rv = *(const v4u*)(V + gbase); ra = *(const v4u*)(A + gbase); rl = *(const v4u*)(LW + gbase);
    for (int c = 0; c < SEQ / RW_CH; ++c) {
        {
            float fr[8], fk[8], fv[8], fa[8], fl[8], kk[8], k2[8], o[8];
            unpack8(rr, fr); unpack8(rk, fk); unpack8(rv, fv); unpack8(ra, fa); unpack8(rl, fl);
            float n2 = 0.f, bs = 0.f;
#pragma unroll
            for (int j = 0; j < 8; ++j) { kk[j] = fk[j] * ckk[j]; n2 += kk[j] * kk[j]; k2[j] = fk[j] * (1.f + (fa[j] - 1.f) * cka[j]); bs += fr[j] * k2[j] * crk[j]; }
            n2 = red8(n2); bs = red8(bs);
            const float inv = 1.f / fmaxf(sqrtf(n2), 1e-12f);
            LAS float* rec = REC + tk * RW_REC + c8;
#pragma unroll
            for (int j = 0; j < 8; ++j) kk[j] *= inv;
            *(LAS f32x4*)(rec + 0 * 64) = (f32x4){kk[0], kk[1], kk[2], kk[3]}; *(LAS f32x4*)(rec + 0 * 64 + 4) = (f32x4){kk[4], kk[5], kk[6], kk[7]};
#pragma unroll
            for (int j = 0; j < 8; ++j) o[j] = __expf(fl[j]);
            *(LAS f32x4*)(rec + 1 * 64) = (f32x4){o[0], o[1], o[2], o[3]}; *(LAS f32x4*)(rec + 1 * 64 + 4) = (f32x4){o[4], o[5], o[6], o[7]};
#pragma unroll
            for (int j = 0; j < 8; ++j) o[j] = kk[j] * fa[j];
            *(LAS f32x4*)(rec + 2 * 64) = (f32x4){o[0], o[1], o[2], o[3]}; *(LAS f32x4*)(rec + 2 * 64 + 4) = (f32x4){o[4], o[5], o[6], o[7]};
            *(LAS f32x4*)(rec + 3 * 64) = (f32x4){k2[0], k2[1], k2[2], k2[3]}; *(LAS f32x4*)(rec + 3 * 64 + 4) = (f32x4){k2[4], k2[5], k2[6], k2[7]};
            *(LAS f32x4*)(rec + 4 * 64) = (f32x4){fr[0], fr[1], fr[2], fr[3]}; *(LAS f32x4*)(rec + 4 * 64 + 4) = (f32x4){fr[4], fr[5], fr[6], fr[7]};
            *(LAS f32x4*)(rec + 5 * 64) = (f32x4){fv[0], fv[1], fv[2], fv[3]}; *(LAS f32x4*)(rec + 5 * 64 + 4) = (f32x4){fv[4], fv[5], fv[6], fv[7]};
            if (rq == 0 && (tid & 7) == 0) bonus[((size_t)b * SEQ + c * RW_CH + tk) * 8 + h] = bs;
        }
        __syncthreads();
        if (c + 1 < SEQ / RW_CH) { const size_t g2 = gbase + (size_t)(c + 1) * RW_CH * 512;
            rr = *(const v4u*)(R + g2); rk = *(const v4u*)(Kk + g2); rv = *(const v4u*)(V + g2); ra = *(const v4u*)(A + g2); rl = *(const v4u*)(LW + g2); }
#pragma unroll 4
        for (int t = 0; t < RW_CH; ++t) {
            const LAS float* rec = REC + t * RW_REC + 2 * kp;
            const f32x2 kk2 = *(const LAS f32x2*)(rec), w2 = *(const LAS f32x2*)(rec + 64), ab2 = *(const LAS f32x2*)(rec + 128), k22 = *(const LAS f32x2*)(rec + 192), r2 = *(const LAS f32x2*)(rec + 256);
            const float vv = REC[t * RW_REC + 320 + rq * 16 + row];
            const float sa = red32(S0 * kk2.x + S1 * kk2.y);
            S0 = S0 * w2.x - sa * ab2.x + vv * k22.x; S1 = S1 * w2.y - sa * ab2.y + vv * k22.y;
            const float y = red32(S0 * r2.x + S1 * r2.y);
            if (kp == 0) YS[t * 16 + row] = y;
        }
        __syncthreads();
        if (tid < 128) { const int t2 = tid >> 1, hf = tid & 1; const LAS float* ys = YS + t2 * 16 + hf * 8;
            float o[8];
#pragma unroll
            for (int j = 0; j < 8; ++j) o[j] = ys[j];
            *(v4u*)(yraw + ((size_t)b * SEQ + c * RW_CH + t2) * 512 + h * 64 + rq * 16 + hf * 8) = pack8(o); }
    }
    __syncthreads();
}

typedef short bf16x8 __attribute__((ext_vector_type(8)));
constexpr int HQ_LD = 136, HT_LD = 72;
constexpr int HL_Q = 0, HL_K = 17408, HL_KHT = 34816, HL_VT = 53248, HL_ATT = 71680, HL_ST = 80896, HL_D = 115712, HL_QT = 116224, HL_RS = 118272;
__device__ __forceinline__ bf16x8 ldfrag(const LAS bf16* base, int ld, int row0, int k0, int lane) { return *(const LAS bf16x8*)(base + (row0 + (lane & 15)) * ld + k0 + 8 * (lane >> 4)); }
template <bool OUT> __device__ __forceinline__ void hgrn_unit(Frame& F, int u, const bf16* cq, const float* nw, bf16* yhg, float* hst, float* hd) {
    LAS bf16* Qs = (LAS bf16*)(F.lds + HL_Q); LAS bf16* Ks = (LAS bf16*)(F.lds + HL_K); LAS bf16* KhT = (LAS bf16*)(F.lds + HL_KHT); LAS bf16* VT = (LAS bf16*)(F.lds + HL_VT);
    LAS bf16* ATT = (LAS bf16*)(F.lds + HL_ATT); LAS bf16* ST = (LAS bf16*)(F.lds + HL_ST); LAS bf16* OT = Ks;
    LAS float* Ds = (LAS float*)(F.lds + HL_D); LAS float* QT = (LAS float*)(F.lds + HL_QT); LAS float* RS = (LAS float*)(F.lds + HL_RS);
    const int b = u >> 5, h = (u >> 3) & 3, sc = u & 7;
    const int tid = F.tid, lane = F.lane, w = F.wave, c = tid & 127, tq = tid >> 7, lr = lane & 15, lq = lane >> 4;
    f32x4 S[8];
#pragma unroll
    for (int j = 0; j < 8; ++j) S[j] = (f32x4){0.f, 0.f, 0.f, 0.f};
    float btot = 0.f;
    if (OUT) {
        for (int j = 0; j < sc; ++j) {
            const int uj = (u & ~7) + j; const float* N = hst + ((size_t)uj * 8 + w) * 32 * 64; const float* Dj = hd + (size_t)uj * 128;
#pragma unroll
            for (int tc = 0; tc < 8; ++tc) { const float d = Dj[tc * 16 + lr];
#pragma unroll
                for (int r = 0; r < 4; ++r) S[tc][r] = S[tc][r] * d + N[(tc * 4 + r) * 64 + lane]; }
        }
#pragma unroll
        for (int tc = 0; tc < 8; ++tc)
#pragma unroll
            for (int r = 0; r < 4; ++r) ST[(w * 16 + 4 * lq + r) * HQ_LD + tc * 16 + lr] = (bf16)f2bf(S[tc][r]);
    }
    for (int ch = 0; ch < 4; ++ch) {
        const size_t tok0 = (size_t)b * SEQ + sc * 256 + ch * 64;
        {
            const bf16* base = cq + (tok0 + tq * 16) * 2048 + h * 128 + c;
            float g[16], bl[16], vv[16], qq[16];
#pragma unroll
            for (int i = 0; i < 16; ++i) { g[i] = bf2f(base[(size_t)i * 2048 + 512]); vv[i] = bf2f(base[(size_t)i * 2048 + 1024]); if (OUT) qq[i] = bf2f(base[(size_t)i * 2048]); }
            float run = 0.f;
#pragma unroll
            for (int i = 0; i < 16; ++i) { run += g[i]; bl[i] = run; }
            QT[tq * 128 + c] = run;
            __syncthreads();
            float off = 0.f, tot = 0.f;
#pragma unroll
            for (int j = 0; j < 4; ++j) { const float x = QT[j * 128 + c]; tot += x; if (j < tq) off += x; }
            float kh[16];
#pragma unroll
            for (int i = 0; i < 16; ++i) {
                const float bb = off + bl[i], k = 1.f - __expf(g[i]);
                kh[i] = k * __expf(tot - bb);
                if (OUT) { Qs[(tq * 16 + i) * HQ_LD + c] = (bf16)f2bf(qq[i] * __expf(bb)); Ks[(tq * 16 + i) * HQ_LD + c] = (bf16)f2bf(k * __expf(-bb)); }
            }
            v4u p0, p1;
            p0.x = pk2(kh[0], kh[1]); p0.y = pk2(kh[2], kh[3]); p0.z = pk2(kh[4], kh[5]); p0.w = pk2(kh[6], kh[7]); p1.x = pk2(kh[8], kh[9]); p1.y = pk2(kh[10], kh[11]); p1.z = pk2(kh[12], kh[13]); p1.w = pk2(kh[14], kh[15]);
            *(LAS v4u*)(KhT + c * HT_LD + tq * 16) = p0; *(LAS v4u*)(KhT + c * HT_LD + tq * 16 + 8) = p1;
            p0.x = pk2(vv[0], vv[1]); p0.y = pk2(vv[2], vv[3]); p0.z = pk2(vv[4], vv[5]); p0.w = pk2(vv[6], vv[7]); p1.x = pk2(vv[8], vv[9]); p1.y = pk2(vv[10], vv[11]); p1.z = pk2(vv[12], vv[13]); p1.w = pk2(vv[14], vv[15]);
            *(LAS v4u*)(VT + c * HT_LD + tq * 16) = p0; *(LAS v4u*)(VT + c * HT_LD + tq * 16 + 8) = p1;
            if (tq == 0) Ds[c] = __expf(tot);
            btot += tot;
        }
        __syncthreads();
        if (OUT) {
            {
                const int tr = w >> 1;
#pragma unroll
                for (int j = 0; j < 2; ++j) { const int tc = (w & 1) * 2 + j;
                    f32x4 a4 = (f32x4){0.f, 0.f, 0.f, 0.f};
                    if (tc <= tr) {
#pragma unroll
                        for (int ks = 0; ks < 4; ++ks) a4 = __builtin_amdgcn_mfma_f32_16x16x32_bf16(ldfrag(Qs, HQ_LD, tr * 16, ks * 32, lane), ldfrag(Ks, HQ_LD, tc * 16, ks * 32, lane), a4, 0, 0, 0);
                    }
#pragma unroll
                    for (int r = 0; r < 4; ++r) { const int t = tr * 16 + 4 * lq + r, s2 = tc * 16 + lr; ATT[t * HT_LD + s2] = (bf16)f2bf(s2 <= t ? a4[r] : 0.f); }
                }
            }
            __syncthreads();
            f32x4 o4[4];
            {
                const int tr = w >> 1;
#pragma unroll
                for (int j = 0; j < 4; ++j) { const int tc = (w & 1) * 4 + j; f32x4 a4 = (f32x4){0.f, 0.f, 0.f, 0.f};
#pragma unroll
                    for (int ks = 0; ks < 2; ++ks) a4 = __builtin_amdgcn_mfma_f32_16x16x32_bf16(ldfrag(ATT, HT_LD, tr * 16, ks * 32, lane), ldfrag(VT, HT_LD, tc * 16, ks * 32, lane), a4, 0, 0, 0);
#pragma unroll
                    for (int ks = 0; ks < 4; ++ks) a4 = __builtin_amdgcn_mfma_f32_16x16x32_bf16(ldfrag(Qs, HQ_LD, tr * 16, ks * 32, lane), ldfrag(ST, HQ_LD, tc * 16, ks * 32, lane), a4, 0, 0, 0);
                    o4[j] = a4; }
#pragma unroll
                for (int r = 0; r < 4; ++r) { float p = o4[0][r] * o4[0][r] + o4[1][r] * o4[1][r] + o4[2][r] * o4[2][r] + o4[3][r] * o4[3][r]; p = red16(p);
                    if (lr == 0) RS[(tr * 16 + 4 * lq + r) * 2 + (w & 1)] = p; }
            }
            __syncthreads();
            {
                const int tr = w >> 1;
#pragma unroll
                for (int r = 0; r < 4; ++r) { const int t = tr * 16 + 4 * lq + r; const float rs = rsqrtf((RS[t * 2] + RS[t * 2 + 1]) * (1.f / 128.f) + RMS_EPS);
#pragma unroll
                    for (int j = 0; j < 4; ++j) OT[t * HQ_LD + ((w & 1) * 4 + j) * 16 + lr] = (bf16)f2bf(o4[j][r] * rs); }
            }
        }
#pragma unroll
        for (int tc = 0; tc < 8; ++tc) { const float d = Ds[tc * 16 + lr]; f32x4 a4 = S[tc] * d;
#pragma unroll
            for (int ks = 0; ks < 2; ++ks) a4 = __builtin_amdgcn_mfma_f32_16x16x32_bf16(ldfrag(VT, HT_LD, w * 16, ks * 32, lane), ldfrag(KhT, HT_LD, tc * 16, ks * 32, lane), a4, 0, 0, 0);
            S[tc] = a4; }
        if (OUT) {
#pragma unroll
            for (int tc = 0; tc < 8; ++tc)
#pragma unroll
                for (int r = 0; r < 4; ++r) ST[(w * 16 + 4 * lq + r) * HQ_LD + tc * 16 + lr] = (bf16)f2bf(S[tc][r]);
        }
        __syncthreads();
        if (OUT) {
#pragma unroll
            for (int i = 0; i < 2; ++i) { const int id = tid + 512 * i, t = id >> 4, c8 = (id & 15) * 8;
                float ot[8], go[8], y[8];
                unpack8(*(const LAS v4u*)(OT + t * HQ_LD + c8), ot); unpack8(*(const v4u*)(cq + (tok0 + t) * 2048 + 1536 + h * 128 + c8), go);
#pragma unroll
                for (int j = 0; j < 8; ++j) y[j] = ot[j] * nw[h * 128 + c8 + j] * go[j];
                *(v4u*)(yhg + (tok0 + t) * 512 + h * 128 + c8) = pack8(y); }
        }
    }
    if (!OUT) {
        float* N = hst + ((size_t)u * 8 + w) * 32 * 64;
#pragma unroll
        for (int tc = 0; tc < 8; ++tc)
#pragma unroll
            for (int r = 0; r < 4; ++r) N[(tc * 4 + r) * 64 + lane] = S[tc][r];
        if (tq == 0) hd[(size_t)u * 128 + c] = __expf(btot);
    }
    __syncthreads();
}

#define CE_(a, b) { const float hi_ = fmaxf(a, b), lo_ = fminf(a, b); a = hi_; b = lo_; }
__device__ __forceinline__ void sort16_desc(float (&x)[16]) {
    CE_(x[0], x[1]) CE_(x[3], x[2]) CE_(x[4], x[5]) CE_(x[7], x[6]) CE_(x[8], x[9]) CE_(x[11], x[10]) CE_(x[12], x[13]) CE_(x[15], x[14]) CE_(x[0], x[2]) CE_(x[1], x[3]) CE_(x[6], x[4]) CE_(x[7], x[5]) CE_(x[8], x[10]) CE_(x[9], x[11]) CE_(x[14], x[12]) CE_(x[15], x[13]) CE_(x[0], x[1]) CE_(x[2], x[3]) CE_(x[5], x[4]) CE_(x[7], x[6]) CE_(x[8], x[9]) CE_(x[10], x[11]) CE_(x[13], x[12]) CE_(x[15], x[14]) CE_(x[0], x[4]) CE_(x[1], x[5]) CE_(x[2], x[6]) CE_(x[3], x[7]) CE_(x[12], x[8]) CE_(x[13], x[9]) CE_(x[14], x[10]) CE_(x[15], x[11]) CE_(x[0], x[2]) CE_(x[1], x[3]) CE_(x[4], x[6]) CE_(x[5], x[7]) CE_(x[10], x[8]) CE_(x[11], x[9]) CE_(x[14], x[12]) CE_(x[15], x[13]) CE_(x[0], x[1]) CE_(x[2], x[3]) CE_(x[4], x[5]) CE_(x[6], x[7]) CE_(x[9], x[8]) CE_(x[11], x[10]) CE_(x[13], x[12]) CE_(x[15], x[14]) CE_(x[0], x[8]) CE_(x[1], x[9]) CE_(x[2], x[10]) CE_(x[3], x[11]) CE_(x[4], x[12]) CE_(x[5], x[13]) CE_(x[6], x[14]) CE_(x[7], x[15]) CE_(x[0], x[4]) CE_(x[1], x[5]) CE_(x[2], x[6]) CE_(x[3], x[7]) CE_(x[8], x[12]) CE_(x[9], x[13]) CE_(x[10], x[14]) CE_(x[11], x[15]) CE_(x[0], x[2]) CE_(x[1], x[3]) CE_(x[4], x[6]) CE_(x[5], x[7]) CE_(x[8], x[10]) CE_(x[9], x[11]) CE_(x[12], x[14]) CE_(x[13], x[15]) CE_(x[0], x[1]) CE_(x[2], x[3]) CE_(x[4], x[5]) CE_(x[6], x[7]) CE_(x[8], x[9]) CE_(x[10], x[11]) CE_(x[12], x[13]) CE_(x[14], x[15])
}
__device__ __forceinline__ void merge16_desc(float (&a)[16], const float (&b)[16]) {
    a[0] = fmaxf(a[0], b[15]); a[1] = fmaxf(a[1], b[14]); a[2] = fmaxf(a[2], b[13]); a[3] = fmaxf(a[3], b[12]); a[4] = fmaxf(a[4], b[11]); a[5] = fmaxf(a[5], b[10]); a[6] = fmaxf(a[6], b[9]); a[7] = fmaxf(a[7], b[8]); a[8] = fmaxf(a[8], b[7]); a[9] = fmaxf(a[9], b[6]); a[10] = fmaxf(a[10], b[5]); a[11] = fmaxf(a[11], b[4]); a[12] = fmaxf(a[12], b[3]); a[13] = fmaxf(a[13], b[2]); a[14] = fmaxf(a[14], b[1]); a[15] = fmaxf(a[15], b[0]);
    CE_(a[0], a[8]) CE_(a[1], a[9]) CE_(a[2], a[10]) CE_(a[3], a[11]) CE_(a[4], a[12]) CE_(a[5], a[13]) CE_(a[6], a[14]) CE_(a[7], a[15]) CE_(a[0], a[4]) CE_(a[1], a[5]) CE_(a[2], a[6]) CE_(a[3], a[7]) CE_(a[8], a[12]) CE_(a[9], a[13]) CE_(a[10], a[14]) CE_(a[11], a[15]) CE_(a[0], a[2]) CE_(a[1], a[3]) CE_(a[4], a[6]) CE_(a[5], a[7]) CE_(a[8], a[10]) CE_(a[9], a[11]) CE_(a[12], a[14]) CE_(a[13], a[15]) CE_(a[0], a[1]) CE_(a[2], a[3]) CE_(a[4], a[5]) CE_(a[6], a[7]) CE_(a[8], a[9]) CE_(a[10], a[11]) CE_(a[12], a[13]) CE_(a[14], a[15])
}

__device__ __forceinline__ void cand_lists(const float (&s0)[16], const float (&s1)[16], bool hh, float (&ca)[16], float (&cb)[16]) {
    { const float v = hh ? (s0[2] + s1[1]) : (s0[0] + s1[0]); const unsigned cd = hh ? 222u : 255u; ca[0] = __builtin_bit_cast(float, (__builtin_bit_cast(unsigned, v) & 0xFFFFFF00u) | cd); }
    { const float v = hh ? (s0[2] + s1[2]) : (s0[0] + s1[1]); const unsigned cd = hh ? 221u : 254u; ca[1] = __builtin_bit_cast(float, (__builtin_bit_cast(unsigned, v) & 0xFFFFFF00u) | cd); }
    { const float v = hh ? (s0[2] + s1[3]) : (s0[0] + s1[2]); const unsigned cd = hh ? 220u : 253u; ca[2] = __builtin_bit_cast(float, (__builtin_bit_cast(unsigned, v) & 0xFFFFFF00u) | cd); }
    { const float v = hh ? (s0[2] + s1[4]) : (s0[0] + s1[3]); const unsigned cd = hh ? 219u : 252u; ca[3] = __builtin_bit_cast(float, (__builtin_bit_cast(unsigned, v) & 0xFFFFFF00u) | cd); }
    { const float v = hh ? (s0[3] + s1[0]) : (s0[0] + s1[4]); const unsigned cd = hh ? 207u : 251u; ca[4] = __builtin_bit_cast(float, (__builtin_bit_cast(unsigned, v) & 0xFFFFFF00u) | cd); }
    { const float v = hh ? (s0[3] + s1[1]) : (s0[0] + s1[5]); const unsigned cd = hh ? 206u : 250u; ca[5] = __builtin_bit_cast(float, (__builtin_bit_cast(unsigned, v) & 0xFFFFFF00u) | cd); }
    { const float v = hh ? (s0[3] + s1[2]) : (s0[0] + s1[6]); const unsigned cd = hh ? 205u : 249u; ca[6] = __builtin_bit_cast(float, (__builtin_bit_cast(unsigned, v) & 0xFFFFFF00u) | cd); }
    { const float v = hh ? (s0[3] + s1[3]) : (s0[0] + s1[7]); const unsigned cd = hh ? 204u : 248u; ca[7] = __builtin_bit_cast(float, (__builtin_bit_cast(unsigned, v) & 0xFFFFFF00u) | cd); }
    { const float v = hh ? (s0[4] + s1[0]) : (s0[0] + s1[8]); const unsigned cd = hh ? 191u : 247u; ca[8] = __builtin_bit_cast(float, (__builtin_bit_cast(unsigned, v) & 0xFFFFFF00u) | cd); }
    { const float v = hh ? (s0[4] + s1[1]) : (s0[0] + s1[9]); const unsigned cd = hh ? 190u : 246u; ca[9] = __builtin_bit_cast(float, (__builtin_bit_cast(unsigned, v) & 0xFFFFFF00u) | cd); }
    { const float v = hh ? (s0[4] + s1[2]) : (s0[0] + s1[10]); const unsigned cd = hh ? 189u : 245u; ca[10] = __builtin_bit_cast(float, (__builtin_bit_cast(unsigned, v) & 0xFFFFFF00u) | cd); }
    { const float v = hh ? (s0[5] + s1[0]) : (s0[0] + s1[11]); const unsigned cd = hh ? 175u : 244u; ca[11] = __builtin_bit_cast(float, (__builtin_bit_cast(unsigned, v) & 0xFFFFFF00u) | cd); }
    { const float v = hh ? (s0[5] + s1[1]) : (s0[0] + s1[12]); const unsigned cd = hh ? 174u : 243u; ca[12] = __builtin_bit_cast(float, (__builtin_bit_cast(unsigned, v) & 0xFFFFFF00u) | cd); }
    { const float v = hh ? (s0[6] + s1[0]) : (s0[0] + s1[13]); const unsigned cd = hh ? 159u : 242u; ca[13] = __builtin_bit_cast(float, (__builtin_bit_cast(unsigned, v) & 0xFFFFFF00u) | cd); }
    { const float v = hh ? (s0[6] + s1[1]) : (s0[0] + s1[14]); const unsigned cd = hh ? 158u : 241u; ca[14] = __builtin_bit_cast(float, (__builtin_bit_cast(unsigned, v) & 0xFFFFFF00u) | cd); }
    { const float v = hh ? (s0[7] + s1[0]) : (s0[0] + s1[15]); const unsigned cd = hh ? 143u : 240u; ca[15] = __builtin_bit_cast(float, (__builtin_bit_cast(unsigned, v) & 0xFFFFFF00u) | cd); }
    { const float v = hh ? (s0[7] + s1[1]) : (s0[1] + s1[0]); const unsigned cd = hh ? 142u : 239u; cb[0] = __builtin_bit_cast(float, (__builtin_bit_cast(unsigned, v) & 0xFFFFFF00u) | cd); }
    { const float v = hh ? (s0[8] + s1[0]) : (s0[1] + s1[1]); const unsigned cd = hh ? 127u : 238u; cb[1] = __builtin_bit_cast(float, (__builtin_bit_cast(unsigned, v) & 0xFFFFFF00u) | cd); }
    { const float v = hh ? (s0[9] + s1[0]) : (s0[1] + s1[2]); const unsigned cd = hh ? 111u : 237u; cb[2] = __builtin_bit_cast(float, (__builtin_bit_cast(unsigned, v) & 0xFFFFFF00u) | cd); }
    { const float v = hh ? (s0[10] + s1[0]) : (s0[1] + s1[3]); const unsigned cd = hh ? 95u : 236u; cb[3] = __builtin_bit_cast(float, (__builtin_bit_cast(unsigned, v) & 0xFFFFFF00u) | cd); }
    { const float v = hh ? (s0[11] + s1[0]) : (s0[1] + s1[4]); const unsigned cd = hh ? 79u : 235u; cb[4] = __builtin_bit_cast(float, (__builtin_bit_cast(unsigned, v) & 0xFFFFFF00u) | cd); }
    { const float v = hh ? (s0[12] + s1[0]) : (s0[1] + s1[5]); const unsigned cd = hh ? 63u : 234u; cb[5] = __builtin_bit_cast(float, (__builtin_bit_cast(unsigned, v) & 0xFFFFFF00u) | cd); }
    { const float v = hh ? (s0[13] + s1[0]) : (s0[1] + s1[6]); const unsigned cd = hh ? 47u : 233u; cb[6] = __builtin_bit_cast(float, (__builtin_bit_cast(unsigned, v) & 0xFFFFFF00u) | cd); }
    { const float v = hh ? (s0[14] + s1[0]) : (s0[1] + s1[7]); const unsigned cd = hh ? 31u : 232u; cb[7] = __builtin_bit_cast(float, (__builtin_bit_cast(unsigned, v) & 0xFFFFFF00u) | cd); }
    { const float v = hh ? (s0[15] + s1[0]) : (s0[2] + s1[0]); const unsigned cd = hh ? 15u : 223u; cb[8] = __builtin_bit_cast(float, (__builtin_bit_cast(unsigned, v) & 0xFFFFFF00u) | cd); }
    cb[9] = -3.0e38f;
    cb[10] = -3.0e38f;
    cb[11] = -3.0e38f;
    cb[12] = -3.0e38f;
    cb[13] = -3.0e38f;
    cb[14] = -3.0e38f;
    cb[15] = -3.0e38f;
}

typedef float f32x16 __attribute__((ext_vector_type(16)));
constexpr int TK_KLD = 72, TK_QLD = 1032;
constexpr int TL_KEYS = 0, TL_Q = 36864, TL_IT = 102912;
__device__ __forceinline__ void topk_half(const LAS bf16* KL, const LAS bf16* QL, int c, int h, int lane, float (&res)[16]) {
    const int hh = lane >> 5, r31 = lane & 31;
    f32x16 acc[4];
#ifdef TOPK_VALU
#pragma unroll
    for (int mt = 0; mt < 4; ++mt)
#pragma unroll
        for (int r = 0; r < 16; ++r) acc[mt][r] = 0.f;
#pragma unroll 1
    for (int d = 0; d < 64; ++d) { const float qv = bf2f(QL[r31 * TK_QLD + h * 128 + c * 64 + d]);
#pragma unroll
        for (int mt = 0; mt < 4; ++mt)
#pragma unroll
            for (int r = 0; r < 16; ++r) acc[mt][r] += bf2f(KL[(c * 128 + mt * 32 + (r & 3) + 8 * (r >> 2) + 4 * hh) * TK_KLD + d]) * qv; }
#else
#pragma unroll
    for (int mt = 0; mt < 4; ++mt)
#pragma unroll
        for (int r = 0; r < 16; ++r) acc[mt][r] = 0.f;
#pragma unroll
    for (int ks = 0; ks < 4; ++ks) {
        const bf16x8 bq = *(const LAS bf16x8*)(QL + r31 * TK_QLD + h * 128 + c * 64 + ks * 16 + 8 * hh);
#pragma unroll
        for (int mt = 0; mt < 4; ++mt) { const bf16x8 ak = *(const LAS bf16x8*)(KL + (c * 128 + mt * 32 + r31) * TK_KLD + ks * 16 + 8 * hh);
            acc[mt] = __builtin_amdgcn_mfma_f32_32x32x16_bf16(ak, bq, acc[mt], 0, 0, 0); }
    }
#endif
    float g0[16], g1[16], g2[16], g3[16];
    const unsigned hb = 4u * (unsigned)hh;
#pragma unroll
    for (int r = 0; r < 16; ++r) { const unsigned nc = (unsigned)((r & 3) + 8 * (r >> 2));
        const float a0 = acc[0][r], a1 = acc[1][r], a2 = acc[2][r], a3 = acc[3][r];
        g0[r] = __builtin_bit_cast(float, (__builtin_bit_cast(unsigned, a0) & 0xFFFFFF80u) | ((127u - nc) - hb));
        g1[r] = __builtin_bit_cast(float, (__builtin_bit_cast(unsigned, a1) & 0xFFFFFF80u) | ((127u - 32u - nc) - hb));
        g2[r] = __builtin_bit_cast(float, (__builtin_bit_cast(unsigned, a2) & 0xFFFFFF80u) | ((127u - 64u - nc) - hb));
        g3[r] = __builtin_bit_cast(float, (__builtin_bit_cast(unsigned, a3) & 0xFFFFFF80u) | ((127u - 96u - nc) - hb)); }
    sort16_desc(g0); sort16_desc(g1); sort16_desc(g2); sort16_desc(g3);
    merge16_desc(g0, g1); merge16_desc(g2, g3); merge16_desc(g0, g2);
    float o[16];
#pragma unroll
    for (int i = 0; i < 16; ++i) o[i] = __shfl_xor(g0[i], 32);
    merge16_desc(g0, o);
#pragma unroll
    for (int i = 0; i < 16; ++i) res[i] = g0[i];
}
__device__ __forceinline__ void topk_unit(Frame& F, int unit, const bf16* qp, int* idx, float* gate) {
    const LAS bf16* KL = (const LAS bf16*)(F.lds + TL_KEYS); LAS bf16* QL = (LAS bf16*)(F.lds + TL_Q);
    LAS unsigned char* ITb = (LAS unsigned char*)(F.lds + TL_IT) + F.wave * 2048 + F.lane * 32;
    const int t0 = unit * 32, tid = F.tid, lane = F.lane, h = F.wave, hh = lane >> 5, r31 = lane & 31;
#pragma unroll
    for (int i = 0; i < 8; ++i) { const int id = tid + 512 * i, r = id >> 7, c16 = id & 127; *(LAS v4u*)(QL + r * TK_QLD + c16 * 8) = *(const v4u*)(qp + (size_t)(t0 + r) * D + c16 * 8); }
    __syncthreads();
    float s0[16], s1[16];
    topk_half(KL, QL, 0, h, lane, s0);
    topk_half(KL, QL, 1, h, lane, s1);
    {
        unsigned w0[4], w1[4];
#pragma unroll
        for (int q = 0; q < 4; ++q) { w0[q] = 0u; w1[q] = 0u;
#pragma unroll
            for (int j = 0; j < 4; ++j) { w0[q] |= (127u - (__builtin_bit_cast(unsigned, s0[q * 4 + j]) & 127u)) << (8 * j); w1[q] |= (127u - (__builtin_bit_cast(unsigned, s1[q * 4 + j]) & 127u)) << (8 * j); } }
        *(LAS v4u*)(ITb) = (v4u){w0[0], w0[1], w0[2], w0[3]}; *(LAS v4u*)(ITb + 16) = (v4u){w1[0], w1[1], w1[2], w1[3]};
    }
#pragma unroll
    for (int i = 0; i < 16; ++i) { s0[i] = __builtin_bit_cast(float, __builtin_bit_cast(unsigned, s0[i]) & 0xFFFFFF80u); s1[i] = __builtin_bit_cast(float, __builtin_bit_cast(unsigned, s1[i]) & 0xFFFFFF80u); }
    float ca[16], cb[16];
    cand_lists(s0, s1, hh != 0, ca, cb);
    sort16_desc(ca); sort16_desc(cb); merge16_desc(ca, cb);
    float o[16];
#pragma unroll
    for (int i = 0; i < 16; ++i) o[i] = __shfl_xor(ca[i], 32);
    merge16_desc(ca, o);
    LDS_WAIT();
    if (hh == 0) {
        float e[16]; int id[16]; float den = 0.f;
        const float m = __builtin_bit_cast(float, __builtin_bit_cast(unsigned, ca[0]) & 0xFFFFFF00u);
#pragma unroll
        for (int k = 0; k < 16; ++k) { const unsigned bits = __builtin_bit_cast(unsigned, ca[k]); const unsigned code = 255u - (bits & 255u);
            e[k] = __expf(__builtin_bit_cast(float, bits & 0xFFFFFF00u) - m); den += e[k];
            const int n0 = ITb[code >> 4], n1 = ITb[16 + (code & 15u)]; id[k] = n0 * 128 + n1; }
        const float inv = 1.f / den;
        int* ip = idx + (size_t)(t0 + r31) * 128 + h * 16; float* gp = gate + (size_t)(t0 + r31) * 128 + h * 16;
#pragma unroll
        for (int q = 0; q < 4; ++q) { *(int4*)(ip + 4 * q) = make_int4(id[4 * q], id[4 * q + 1], id[4 * q + 2], id[4 * q + 3]);
            *(f32x4*)(gp + 4 * q) = (f32x4){e[4 * q] * inv, e[4 * q + 1] * inv, e[4 * q + 2] * inv, e[4 * q + 3] * inv}; }
    }
    __syncthreads();
}

#ifndef PG8_SP2
#define PG8_SP2 true
#endif
#ifndef PG8_ALIGN
#define PG8_ALIGN true
#endif
template <class E> __device__ __forceinline__ void run_gemm(Frame& F, const bf16* A, const bf16* Bt, int M, int N, int K, const E& e) {
    pg8::Gemm g{A, Bt, M, N, K}; pg8::StaticOrder S; S.init(M, N, F.G, (int)blockIdx.x);
    EpiAdapt<E> EA{e};
    pg8::gemm_phase<EpiAdapt<E>, pg8::StaticOrder, PG8_ALIGN, PG8_SP2>(F.lds + RING_OFF, g, S, EA);
}

__global__ void __launch_bounds__(NTHR, 2) fwd(Args args) {
    extern __shared__ __attribute__((aligned(16))) unsigned char lds_raw[];
    Frame F;
    F.lds = (LAS unsigned char*)lds_raw;
    F.tid = threadIdx.x; F.lane = F.tid & 63; F.wave = __builtin_amdgcn_readfirstlane(F.tid >> 6);
    F.G = gridDim.x; { const int bx = blockIdx.x; F.vcu = (F.G % 8 == 0) ? (bx % 8) * (F.G / 8) + bx / 8 : bx; }
    unsigned char* ws = args.ws; unsigned char* dout = (unsigned char*)args.out;
    unsigned* ctl = (unsigned*)(ws + WS_CTL);
    for (int u = F.tid; u < (LDS_BYTES - LDSCTL_OFF) / 4; u += NTHR) ((LAS unsigned*)(F.lds + LDSCTL_OFF))[u] = 0u;
    __syncthreads();
    volatile LAS unsigned* MISC = (volatile LAS unsigned*)(F.lds + MISC_OFF);
    XcdBarrier bar = xcd_barrier_post(ctl + CW_BAR + args.li * XCD_BAR_WORDS, MISC + 8);
    const int lo = args.ph_lo, hi = args.ph_hi;
#ifndef PHMASK
#define PHMASK 0xFFFFFFFFu
#endif
#define IN(k) ((((PHMASK) >> (k)) & 1u) && lo <= (k) && (k) < hi)
#define SEAM(k) do { if (IN(k) && IN((k) + 1)) xcd_barrier(bar); } while (0)

    const float* const* in = args.in;
    float* SS2 = (float*)(ws + CTL_SS2); float* SS4 = (float*)(ws + CTL_SS4);
    float* R1 = (float*)(ws + SM_R1); float* R3 = (float*)(ws + SM_R3); float* LB = (float*)(ws + SM_LB); float* BONUS = (float*)(ws + SM_BONUS);
    bf16 *WIN = (bf16*)(ws + WS_WIN), *WBH = (bf16*)(ws + WS_WBH), *WBR = (bf16*)(ws + WS_WBR), *WOUT = (bf16*)(ws + WS_WOUT), *WQ = (bf16*)(ws + WS_WQ), *WPG = (bf16*)(ws + WS_WPG),
         *WPP = (bf16*)(ws + WS_WPP), *WLORA = (bf16*)(ws + WS_WLORA);
    bf16 *XB = (bf16*)(ws + WS_XB), *LW = (bf16*)(ws + WS_LW), *AA = (bf16*)(ws + WS_A), *YRW = (bf16*)(ws + WS_YRW), *PB = (bf16*)(ws + WS_PB);
    bf16 *CQ = (bf16*)(ws + WS_CQ), *M1 = (bf16*)(ws + WS_M1), *MERGED = (bf16*)(ws + WS_MERGED), *UT = (bf16*)(ws + WS_UT), *VT = (bf16*)(ws + WS_VT);
    bf16 *CRW = (bf16*)(ws + WS_CRW), *G = (bf16*)(ws + WS_G), *YRAW = (bf16*)(ws + WS_YRAW); int* IDX = (int*)(ws + WS_IDX); float* GATE = (float*)(ws + WS_GATE);
    float* HST = (float*)(ws + WS_HST); float* HD = (float*)(ws + WS_HST + 16 * MiB);
    bf16 *CG = (bf16*)(ws + WS_CG), *X1B = (bf16*)(ws + WS_X1B), *QP = (bf16*)(ws + WS_QP), *X2B = (bf16*)(ws + WS_X2B), *T2 = (bf16*)(ws + WS_T2);
    bf16 *RR = (bf16*)(dout + DO_R), *KK = (bf16*)(dout + DO_K), *VV = (bf16*)(dout + DO_V), *LIN = (bf16*)(dout + DO_LIN), *YHG = (bf16*)(dout + DO_YHG);
    float* XO = args.out;
    const int gw = F.vcu * NWAVES + F.wave, NGW = F.G * NWAVES;
    const size_t gtid = (size_t)F.vcu * NTHR + F.tid, NGT = (size_t)F.G * NTHR;

    if (IN(PH_PRO)) {
        LAS float* scr = (LAS float*)(F.lds + RING_OFF + F.wave * 16384);
        constexpr int I_IN = (D / 64) * (INC / 32), I_B = (512 / 64) * (D / 32), I_SQ = (D / 64) * (D / 32), I_PP = (PLE / 64) * (D / 32), I_L64 = 1 * (512 / 32), I_L128 = 2 * (512 / 32);
        constexpr int NITEMS = I_IN + 2 * I_B + 3 * I_SQ + I_PP + 2 * I_L64 + I_L128;
        for (int it = gw; it < NITEMS; it += NGW) {
            int r = it;
            if (r < I_IN) { tr_item(in[3], in[2], D, INC, WIN, D, 0, 0, scr, r, F.lane); continue; } r -= I_IN;
            if (r < I_B) { tr_item(in[17], nullptr, 512, D, WBH, 512, 0, 0, scr, r, F.lane); continue; } r -= I_B;
            if (r < I_B) { tr_item(in[18], nullptr, 512, D, WBR, 512, 0, 0, scr, r, F.lane); continue; } r -= I_B;
            if (r < I_SQ) { tr_item(in[19], nullptr, D, D, WOUT, D, 0, 0, scr, r, F.lane); continue; } r -= I_SQ;
            if (r < I_SQ) { tr_item(in[21], in[20], D, D, WQ, D, 0, 0, scr, r, F.lane); continue; } r -= I_SQ;
            if (r < I_SQ) { tr_item(in[27], in[25], D, D, WPG, D, 0, 0, scr, r, F.lane); continue; } r -= I_SQ;
            if (r < I_PP) { tr_item(in[26], nullptr, PLE, D, WPP, PLE, 0, 0, scr, r, F.lane); continue; } r -= I_PP;
            if (r < I_L64) { tr_item(in[8], nullptr, 64, 512, WLORA, 256, 0, 0, scr, r, F.lane); continue; } r -= I_L64;
            if (r < I_L64) { tr_item(in[10], nullptr, 64, 512, WLORA, 256, 64, 512, scr, r, F.lane); continue; } r -= I_L64;
            tr_item(in[11], nullptr, 128, 512, WLORA, 256, 128, 1024, scr, r, F.lane);
        }
        for (size_t c = gtid; c < (size_t)1536 * 32; c += NGT) {
            const int row = (int)(c / 32), col = (int)(c % 32) * 8, blk = row / 512;
            const bool diag = (blk == 0 && col < 64) || (blk == 1 && col >= 64 && col < 128) || (blk == 2 && col >= 128);
            if (!diag) *(v4u*)(WLORA + (size_t)row * 256 + col) = (v4u){0u, 0u, 0u, 0u};
        }
        if (F.vcu == 0) { const int c = F.tid; const float a = in[4][c], b = in[4][512 + c], m = fmaxf(a, b); const float ea = __expf(a - m), eb = __expf(b - m); LB[c] = ea / (ea + eb); }
        for (int m = gw; m < T; m += NGW) xprep_row(in[0], XB, R1, m, F.lane);
        for (size_t c = gtid; c < (size_t)T * PLE / 8; c += NGT) {
            const f32x4 a = ((const f32x4*)in[1])[2 * c], b = ((const f32x4*)in[1])[2 * c + 1];
            v4u w; w.x = pk2(a.x, a.y); w.y = pk2(a.z, a.w); w.z = pk2(b.x, b.y); w.w = pk2(b.z, b.w);
            ((v4u*)PB)[c] = w;
        }
    }
    SEAM(PH_PRO);
    if (IN(PH_GEMM1)) run_gemm(F, XB, WIN, T, INC, D, EpiIn{R1, LB, CQ, CRW, CG});
    SEAM(PH_GEMM1);
    if (IN(PH_RWSHIFT)) {
        const float* mu = in[6];
        for (size_t c = gtid; c < (size_t)T * (RWC / 8); c += NGT) {
            const int t = (int)(c / (RWC / 8)), col = (int)(c % (RWC / 8)) * 8;
            float cur[8], prev[8], o[8];
            unpack8(*(const v4u*)(CRW + (size_t)t * RWC + col), cur);
            if (t % SEQ) unpack8(*(const v4u*)(CRW + (size_t)(t - 1) * RWC + col), prev);
            else {
#pragma unroll
                for (int j = 0; j < 8; ++j) prev[j] = 0.f; }
#pragma unroll
            for (int j = 0; j < 8; ++j) o[j] = cur[j] + (prev[j] - cur[j]) * mu[col + j];
            if (col < 512) *(v4u*)(RR + (size_t)t * 512 + col) = pack8(o);
            else if (col < 1024) *(v4u*)(KK + (size_t)t * 512 + col - 512) = pack8(o);
            else if (col < 1536) *(v4u*)(VV + (size_t)t * 512 + col - 1024) = pack8(o);
            else {
                if (col < 1600) {
#pragma unroll
                    for (int j = 0; j < 8; ++j) o[j] = tanhf(o[j]);
                } else if (col >= 1664) {
#pragma unroll
                    for (int j = 0; j < 8; ++j) o[j] = sigmoidf_(o[j]);
                }
                *(v4u*)(LIN + (size_t)t * 256 + col - 1536) = pack8(o);
            }
        }
    }
    SEAM(PH_RWSHIFT);
    if (IN(PH_LORA)) {
        run_gemm(F, LIN, WLORA, T, 1536, 256, EpiLora{in[7], in[9], LW, AA, G});
        for (int u = F.vcu; u < 256; u += F.G) hgrn_unit<false>(F, u, CQ, in[5], YHG, HST, HD);
    }
    SEAM(PH_LORA);
    if (IN(PH_HGRN)) {
        for (int u = F.vcu; u < 256; u += F.G) hgrn_unit<true>(F, u, CQ, in[5], YHG, HST, HD);
    }
    SEAM(PH_HGRN);
    if (IN(PH_RWKV)) {
        for (int item = F.vcu; item < BATCH * RWH * 4; item += F.G) rwkv_item(F, item, RR, KK, VV, LW, AA, in[12], in[13], in[14], YRAW, BONUS);
    }
    SEAM(PH_RWKV);
    if (IN(PH_RWPOST)) {
        const float* ln_w = in[15]; const float* ln_b = in[16];
        for (int w = gw; w < T * RWH; w += NGW) {
            const int t = w / RWH, h = w % RWH, c = h * 64 + F.lane; const size_t o = (size_t)t * 512 + c;
            const float y = bf2f(YRAW[o]);
            const float mean = wave_sum(y) * (1.f / 64.f); const float d = y - mean; const float var = wave_sum(d * d) * (1.f / 64.f);
            float r = d * rsqrtf(var + GN_EPS) * ln_w[c] + ln_b[c];
            r = (r + BONUS[(size_t)t * 8 + h] * bf2f(VV[o])) * bf2f(G[o]);
            YRW[o] = (bf16)f2bf(r);
        }
    }
    SEAM(PH_RWPOST);
    if (IN(PH_BR)) {
        run_gemm(F, YHG, WBH, T, D, 512, EpiBranch1{CG, M1});
        run_gemm(F, YRW, WBR, T, D, 512, EpiBranch2{CG, M1, MERGED});
    }
    SEAM(PH_BR);
    if (IN(PH_OUT)) run_gemm(F, MERGED, WOUT, T, D, D, EpiOut{in[0], XO, X1B, SS2});
    SEAM(PH_OUT);
    if (IN(PH_QG)) {
        run_gemm(F, X1B, WQ, T, D, D, EpiQ{SS2, QP});
        for (size_t c = gtid; c < (size_t)NEXP * D / 8; c += NGT) {
            { const f32x4 a = ((const f32x4*)in[23])[2 * c], b = ((const f32x4*)in[23])[2 * c + 1]; v4u w; w.x = pk2(a.x, a.y); w.y = pk2(a.z, a.w); w.z = pk2(b.x, b.y); w.w = pk2(b.z, b.w); ((v4u*)UT)[c] = w; }
            { const f32x4 a = ((const f32x4*)in[24])[2 * c], b = ((const f32x4*)in[24])[2 * c + 1]; v4u w; w.x = pk2(a.x, a.y); w.y = pk2(a.z, a.w); w.z = pk2(b.x, b.y); w.w = pk2(b.z, b.w); ((v4u*)VT)[c] = w; }
        }
    }
    SEAM(PH_QG);
    if (IN(PH_TOPK)) {
        {
            LAS bf16* KL = (LAS bf16*)(F.lds + TL_KEYS);
#pragma unroll
            for (int i = 0; i < 8; ++i) { const int id = F.tid + 512 * i, row = id >> 4, c4 = (id & 15) * 4; const f32x4 kv = *(const f32x4*)(in[22] + (size_t)row * 64 + c4);
                v2u pk; pk.x = pk2(kv.x, kv.y); pk.y = pk2(kv.z, kv.w); *(LAS v2u*)(KL + row * TK_KLD + c4) = pk; }
        }
        for (int unit = F.vcu; unit < T / 32; unit += F.G) topk_unit(F, unit, QP, IDX, GATE);
        __syncthreads();
    }
    SEAM(PH_TOPK);
    if (IN(PH_GATHER)) {
        for (int t = gw; t < T; t += NGW)
            peer_token(XO + (size_t)t * D, SS2[t], in[20], UT, VT, IDX + (size_t)t * 128, GATE + (size_t)t * 128, X2B + (size_t)t * D, R3 + t, F.lane);
    }
    SEAM(PH_GATHER);
    if (IN(PH_PLE)) {
        run_gemm(F, PB, WPP, T, D, PLE, EpiPP{T2});
        run_gemm(F, X2B, WPG, T, D, D, EpiPG{R3, T2, XO, SS4});
    }
    SEAM(PH_PLE);
    if (IN(PH_FINAL)) {
        const float* fw = in[28];
        for (int row = gw; row < T; row += NGW) {
            const float r = rsqrtf(SS4[row] * (1.f / D) + RMS_EPS);
            f32x4* xr = (f32x4*)(XO + (size_t)row * D) + F.lane; const f32x4* w = (const f32x4*)fw + F.lane;
#pragma unroll
            for (int j = 0; j < 4; ++j) { f32x4 v = xr[64 * j]; const f32x4 ww = w[64 * j]; v.x *= r * ww.x; v.y *= r * ww.y; v.z *= r * ww.z; v.w *= r * ww.w; xr[64 * j] = v; }
        }
    }
#undef IN
#undef SEAM
}

extern "C" void kernel_launch(void* const* d_in, const int* in_sizes, int n_in, void* d_out, int out_size, void* d_ws, size_t ws_size, hipStream_t stream) {
    static int grid = 0;
    if (grid == 0) {
        if (n_in != 29 || ws_size < WS_END || out_size != T * D) { fprintf(stderr, "kernel_launch: unexpected n_in %d / ws %zu / out %d\n", n_in, ws_size, out_size); grid = -1; return; }
        int dev = 0, cus = 0, per_cu = 0;
        if (hipGetDevice(&dev) != hipSuccess || hipDeviceGetAttribute(&cus, hipDeviceAttributeMultiprocessorCount, dev) != hipSuccess) { grid = -1; return; }
        if (hipFuncSetAttribute((const void*)fwd, hipFuncAttributeMaxDynamicSharedMemorySize, LDS_BYTES) != hipSuccess) { fprintf(stderr, "kernel_launch: hipFuncSetAttribute failed\n"); grid = -1; return; }
        if (hipOccupancyMaxActiveBlocksPerMultiprocessor(&per_cu, (const void*)fwd, NTHR, LDS_BYTES) != hipSuccess || per_cu < 1) fprintf(stderr, "kernel_launch: occupancy query says %d\n", per_cu);
        (void)hipGetLastError();
        grid = cus;
    }
    if (grid < 0) return;
    unsigned char* ws = (unsigned char*)d_ws; unsigned char* dout = (unsigned char*)d_out;
    (void)hipMemsetAsync(ws + WS_CTL, 0, CTL_ZERO_BYTES, stream);
    Args a{};
    for (int i = 0; i < 29; ++i) a.in[i] = (const float*)d_in[i];
    a.out = (float*)d_out; a.ws = ws;
    int li = 0;
    auto run = [&](int lo, int hi) { a.ph_lo = lo; a.ph_hi = hi; a.li = li++; hipLaunchKernelGGL(fwd, dim3(grid), dim3(NTHR), LDS_BYTES, stream, a); };
    const float* const* in = (const float* const*)d_in;
    bf16 *LW = (bf16*)(ws + WS_LW), *AA = (bf16*)(ws + WS_A), *CQ = (bf16*)(ws + WS_CQ), *YRAW = (bf16*)(ws + WS_YRAW), *QP = (bf16*)(ws + WS_QP);
    bf16 *RR = (bf16*)(dout + DO_R), *KK = (bf16*)(dout + DO_K), *VV = (bf16*)(dout + DO_V), *YHG = (bf16*)(dout + DO_YHG);
    int* IDX = (int*)(ws + WS_IDX); float* GATE = (float*)(ws + WS_GATE); float* BONUS = (float*)(ws + SM_BONUS);
    run(PH_PRO, PH_N);
}
```

```cpp
#include <hip/hip_runtime.h>
#include <cstdio>
#include <cstdint>
#include <utility>

constexpr int D = 1024, BATCH = 8, SEQ = 2048, T = BATCH * SEQ;
constexpr int INC = 5888;
constexpr int HGW = 512, HGH = 4, HGD = 128;
constexpr int RWW = 512, RWH = 8, RWD = 64, RWC = 1792;
constexpr int NEXP = 16384, NKEYS = 128, PKH = 8, PKTOP = 16, PKHALF = 64;
constexpr int PLE = 256;
constexpr float RMS_EPS = 1e-6f, GN_EPS = 64e-5f;

typedef unsigned short bf16;
typedef unsigned v4u __attribute__((ext_vector_type(4)));
typedef unsigned v2u __attribute__((ext_vector_type(2)));
typedef float f32x4 __attribute__((ext_vector_type(4)));
typedef float f32x2 __attribute__((ext_vector_type(2)));

constexpr size_t MiB = 1u << 20;
constexpr size_t WS_CTL = 0, CTL_ZERO_BYTES = 1 * MiB;
constexpr size_t CTL_SS2 = 256 * 1024, CTL_SS3 = 320 * 1024, CTL_SS4 = 384 * 1024;
constexpr size_t WS_SMALL = 1 * MiB;
constexpr size_t SM_R1 = WS_SMALL, SM_R3 = WS_SMALL + 64 * 1024, SM_LB = WS_SMALL + 128 * 1024, SM_BONUS = WS_SMALL + 256 * 1024;
constexpr size_t WS_WIN = 2 * MiB;
constexpr size_t WS_WBH = 14 * MiB;
constexpr size_t WS_WBR = 15 * MiB;
constexpr size_t WS_WOUT = 16 * MiB;
constexpr size_t WS_WQ = 18 * MiB;
constexpr size_t WS_WPG = 20 * MiB;
constexpr size_t WS_WPP = 22 * MiB;
constexpr size_t WS_WLORA = 22 * MiB + 512 * 1024;
constexpr size_t WS_XB = 24 * MiB;
constexpr size_t WS_LW = WS_XB, WS_A = WS_XB + 16 * MiB, WS_YRW = WS_XB;
constexpr size_t WS_PB = 56 * MiB;
constexpr size_t WS_CQ = 64 * MiB;
constexpr size_t WS_M1 = WS_CQ, WS_MERGED = WS_CQ + 32 * MiB, WS_UT = WS_CQ, WS_VT = WS_CQ + 32 * MiB;
constexpr size_t WS_CRW = 128 * MiB;
constexpr size_t WS_G = WS_CRW, WS_HST = WS_CRW + 16 * MiB, WS_YRAW = WS_CRW + 36 * MiB, WS_IDX = WS_CRW, WS_GATE = WS_CRW + 8 * MiB;
constexpr size_t WS_CG = 184 * MiB;
constexpr size_t WS_X1B = WS_CG, WS_QP = WS_CG + 32 * MiB, WS_X2B = WS_CG, WS_T2 = WS_CG + 32 * MiB;
constexpr size_t WS_END = 256 * MiB;
constexpr size_t DO_R = 0, DO_K = 16 * MiB, DO_V = 32 * MiB, DO_LIN = 48 * MiB, DO_YHG = 48 * MiB;

__device__ __forceinline__ unsigned f2bf(float f) { unsigned u = __builtin_bit_cast(unsigned, f); return (u + 0x7fffu + ((u >> 16) & 1u)) >> 16; }
__device__ __forceinline__ unsigned pk2(float lo, float hi) { return f2bf(lo) | (f2bf(hi) << 16); }
__device__ __forceinline__ float bf2f(bf16 b) { return __builtin_bit_cast(float, ((unsigned)b) << 16); }
__device__ __forceinline__ float bflo(unsigned u) { return __builtin_bit_cast(float, u << 16); }
__device__ __forceinline__ float bfhi(unsigned u) { return __builtin_bit_cast(float, u & 0xffff0000u); }
__device__ __forceinline__ float sigmoidf_(float x) { return 1.f / (1.f + __expf(-x)); }
__device__ __forceinline__ float siluf_(float x) { return x / (1.f + __expf(-x)); }
__device__ __forceinline__ float wave_sum(float v) {
#pragma unroll
    for (int o = 1; o < 64; o <<= 1) v += __shfl_xor(v, o);
    return v;
}
__device__ __forceinline__ void unpack8(v4u w, float (&f)[8]) {
    f[0] = bflo(w.x); f[1] = bfhi(w.x); f[2] = bflo(w.y); f[3] = bfhi(w.y); f[4] = bflo(w.z); f[5] = bfhi(w.z); f[6] = bflo(w.w); f[7] = bfhi(w.w);
}
__device__ __forceinline__ v4u pack8(const float (&f)[8]) { v4u w; w.x = pk2(f[0], f[1]); w.y = pk2(f[2], f[3]); w.z = pk2(f[4], f[5]); w.w = pk2(f[6], f[7]); return w; }

struct EpiIn {
    const float* r1; const float* lb; bf16* cq; bf16* crw; bf16* cg;
    __device__ __forceinline__ void apply8(int row, int col0, float (&v)[8]) const {
        const float r = r1[row];
        float o[8];
        if (col0 < 512) {
#pragma unroll
            for (int j = 0; j < 8; ++j) o[j] = siluf_(v[j] * r) * 0.08838834764831845f;
            *(v4u*)(cq + (size_t)row * 2048 + col0) = pack8(o);
        } else if (col0 < 1024) {
#pragma unroll
            for (int j = 0; j < 8; ++j) { const float l = lb[col0 - 512 + j]; const float f = l + (1.f - l) * sigmoidf_(v[j] * r); o[j] = __logf(f); }
            *(v4u*)(cq + (size_t)row * 2048 + col0) = pack8(o);
        } else if (col0 < 1536) {
#pragma unroll
            for (int j = 0; j < 8; ++j) o[j] = v[j] * r;
            *(v4u*)(cq + (size_t)row * 2048 + col0) = pack8(o);
        } else if (col0 < 2048) {
#pragma unroll
            for (int j = 0; j < 8; ++j) o[j] = siluf_(v[j] * r);
            *(v4u*)(cq + (size_t)row * 2048 + col0) = pack8(o);
        } else if (col0 < 3840) {
#pragma unroll
            for (int j = 0; j < 8; ++j) o[j] = v[j] * r;
            *(v4u*)(crw + (size_t)row * RWC + (col0 - 2048)) = pack8(o);
        } else {
#pragma unroll
            for (int j = 0; j < 8; ++j) o[j] = sigmoidf_(v[j] * r);
            *(v4u*)(cg + (size_t)row * 2048 + (col0 - 3840)) = pack8(o);
        }
    }
};
struct EpiLora {
    const float* w0; const float* a0; bf16* lw; bf16* a; bf16* g;
    __device__ __forceinline__ void apply8(int row, int col0, float (&v)[8]) const {
        float o[8];
        if (col0 < 512) {
#pragma unroll
            for (int j = 0; j < 8; ++j) { const float z = -(w0[col0 + j] + v[j]); const float sp = fmaxf(z, 0.f) + log1pf(__expf(-fabsf(z))); o[j] = -__expf(-sp - 0.5f); }
            *(v4u*)(lw + (size_t)row * 512 + col0) = pack8(o);
        } else if (col0 < 1024) {
#pragma unroll
            for (int j = 0; j < 8; ++j) o[j] = sigmoidf_(a0[col0 - 512 + j] + v[j]);
            *(v4u*)(a + (size_t)row * 512 + col0 - 512) = pack8(o);
        } else {
            *(v4u*)(g + (size_t)row * 512 + col0 - 1024) = pack8(v);
        }
    }
};
struct EpiBranch1 {
    const bf16* cg; bf16* m1;
    __device__ __forceinline__ void apply8(int row, int col0, float (&v)[8]) const {
        float gt[8]; unpack8(*(const v4u*)(cg + (size_t)row * 2048 + col0), gt);
        float o[8];
#pragma unroll
        for (int j = 0; j < 8; ++j) o[j] = gt[j] * v[j];
        *(v4u*)(m1 + (size_t)row * 1024 + col0) = pack8(o);
    }
};
struct EpiBranch2 {
    const bf16* cg; const bf16* m1; bf16* mg;
    __device__ __forceinline__ void apply8(int row, int col0, float (&v)[8]) const {
        float gt[8], p[8]; unpack8(*(const v4u*)(cg + (size_t)row * 2048 + 1024 + col0), gt); unpack8(*(const v4u*)(m1 + (size_t)row * 1024 + col0), p);
        float o[8];
#pragma unroll
        for (int j = 0; j < 8; ++j) o[j] = p[j] + gt[j] * v[j];
        *(v4u*)(mg + (size_t)row * 1024 + col0) = pack8(o);
    }
};
struct EpiOut {
    const float* x; float* x1; bf16* x1b;
    __device__ __forceinline__ void apply8(int row, int col0, float (&v)[8]) const {
        const f32x4 a = *(const f32x4*)(x + (size_t)row * D + col0), b = *(const f32x4*)(x + (size_t)row * D + col0 + 4);
        float o[8] = {a.x + v[0], a.y + v[1], a.z + v[2], a.w + v[3], b.x + v[4], b.y + v[5], b.z + v[6], b.w + v[7]};
        *(f32x4*)(x1 + (size_t)row * D + col0) = (f32x4){o[0], o[1], o[2], o[3]};
        *(f32x4*)(x1 + (size_t)row * D + col0 + 4) = (f32x4){o[4], o[5], o[6], o[7]};
        *(v4u*)(x1b + (size_t)row * D + col0) = pack8(o);
    }
};
struct EpiQ {
    bf16* qp;
    __device__ __forceinline__ void apply8(int row, int col0, float (&v)[8]) const { *(v4u*)(qp + (size_t)row * D + col0) = pack8(v); }
};
struct EpiPP {
    bf16* t2;
    __device__ __forceinline__ void apply8(int row, int col0, float (&v)[8]) const { *(v4u*)(t2 + (size_t)row * D + col0) = pack8(v); }
};
struct EpiPG {
    const float* ss3; const bf16* t2; float* xio;
    __device__ __forceinline__ void apply8(int row, int col0, float (&v)[8]) const {
        const float r = rsqrtf(ss3[row] * (1.f / D) + RMS_EPS);
        float t[8]; unpack8(*(const v4u*)(t2 + (size_t)row * D + col0), t);
        const f32x4 a = *(const f32x4*)(xio + (size_t)row * D + col0), b = *(const f32x4*)(xio + (size_t)row * D + col0 + 4);
        float xin[8] = {a.x, a.y, a.z, a.w, b.x, b.y, b.z, b.w}, o[8];
#pragma unroll
        for (int j = 0; j < 8; ++j) o[j] = xin[j] + sigmoidf_(v[j] * r) * t[j];
        *(f32x4*)(xio + (size_t)row * D + col0) = (f32x4){o[0], o[1], o[2], o[3]};
        *(f32x4*)(xio + (size_t)row * D + col0 + 4) = (f32x4){o[4], o[5], o[6], o[7]};
    }
};


namespace pg8 {
#define PG8_LAS __attribute__((address_space(3)))
typedef unsigned short bf16_t;
typedef short bf16x8 __attribute__((ext_vector_type(8)));
typedef float f32x4 __attribute__((ext_vector_type(4)));
typedef unsigned u32x4 __attribute__((ext_vector_type(4)));
constexpr int BM = 256, BK = 64, HALF = 128, HTB = HALF * BK * 2  , STAGE_BYTES = 8 * HTB, NXCD = 8, WGM = 8;

__host__ __device__ __forceinline__ int lds_byte(int r, int c) { const int st = (r >> 4) * 2 + (c >> 5), rr = r & 15, cc = c & 31, ob = rr * 64 + cc * 2; return st * 1024 + (ob ^ (((ob >> 9) & 1) << 5)); }
__host__ __device__ __forceinline__ void stage_rc(int b, int& R, int& C) { const int st = b / 1024, sb = b % 1024, swz = sb ^ (((sb >> 9) & 1) << 5); R = (st >> 1) * 16 + swz / 64; C = (st & 1) * 32 + (swz % 64) / 2; }
__host__ __device__ __forceinline__ int perm32(int rho) { const int n = rho >> 4, i = rho & 15; return 8 * (i >> 2) + 4 * n + (i & 3); }

struct Unit { int pm, pn; };
struct Gemm { const bf16_t* A; const bf16_t* Bt; int M, N, K; };

struct StaticOrder {
    int nM, nN, nwg, G, c;
    __host__ __device__ void init(int M, int N, int G_, int c_) { nM = M / BM; nN = N / BM; nwg = nM * nN; G = G_; c = c_; }
    __host__ __device__ bool next(int i, Unit& u) const {
        const long L = (long)i * G + c; if (L >= nwg) return false;
        int wgid = (int)L; { const int q = nwg / NXCD, r = nwg % NXCD, xcd = wgid % NXCD, off = wgid / NXCD; wgid = (xcd < r ? xcd * (q + 1) : r * (q + 1) + (xcd - r) * q) + off; }
        const int nig = WGM * nN, gid = wgid / nig, fm = gid * WGM, gsz = (nM - fm) < WGM ? (nM - fm) : WGM;
        u.pm = fm + ((wgid % nig) % gsz); u.pn = (wgid % nig) / gsz; return true;
    }
    __device__ __forceinline__ void a_ready(const Unit&) const {}
    __device__ __forceinline__ void done(const Unit&) const {}
};

template <class Epi, class Sched, bool ALIGN_EPI = false, bool SP2 = false>
__device__ __forceinline__ void gemm_phase(PG8_LAS unsigned char* lds, const Gemm g, const Sched& S, const Epi& E) {
    const int tid = threadIdx.x, wid = __builtin_amdgcn_readfirstlane(tid >> 6), lane = tid & 63, wr = wid >> 2, wc = wid & 3, fr = lane & 15, fq = lane >> 4;
    const int K = g.K, nt = K / BK;
    unsigned voffA[2], voffB[2];
#pragma unroll
    for (int i = 0; i < 2; ++i) { int R, C; stage_rc(tid * 16 + i * 8192, R, C); const int Rb = Epi::PERM ? ((R & ~31) + perm32(R & 31)) : R;
        voffA[i] = (unsigned)(R * K + C) * 2u; voffB[i] = (unsigned)(Rb * K + C) * 2u; }
    const size_t kstep = (size_t)(BK * 2);
    const size_t hstep = (size_t)HALF * K * 2;
    const size_t tstep = 2 * hstep;
    const unsigned ldsw = (unsigned)wid * 1024u;
    const int aoff = lds_byte(wr * 64 + fr, fq * 8), boff = lds_byte(wc * 32 + fr, fq * 8);
#define PG8_SA(b, h) (((b) * 2 + (h)) * HTB)
#define PG8_SB(b, h) ((4 + (b) * 2 + (h)) * HTB)
#define PG8_STAGE(bufoff, gbase, voff) do { _Pragma("unroll") for (int _i = 0; _i < 2; ++_i) \
        __builtin_amdgcn_global_load_lds((const unsigned*)((const char*)(gbase) + (voff)[_i]), (PG8_LAS unsigned*)(lds + (bufoff) + ldsw + _i * 8192), 16, 0, 0); } while (0)
#define PG8_LDA(dst, b, h) do { _Pragma("unroll") for (int m = 0; m < 4; ++m) _Pragma("unroll") for (int k = 0; k < 2; ++k) dst[m][k] = *(const PG8_LAS bf16x8*)(lds + PG8_SA(b, h) + aoff + m * 2048 + k * 1024); } while (0)
#define PG8_LDB(dst, b, h) do { _Pragma("unroll") for (int n = 0; n < 2; ++n) _Pragma("unroll") for (int k = 0; k < 2; ++k) dst[n][k] = *(const PG8_LAS bf16x8*)(lds + PG8_SB(b, h) + boff + n * 2048 + k * 1024); } while (0)
#define PG8_MMA(ai, bj, At, Bt) do { __builtin_amdgcn_s_setprio(1); _Pragma("unroll") for (int m = 0; m < 4; ++m) _Pragma("unroll") for (int n = 0; n < 2; ++n) _Pragma("unroll") for (int k = 0; k < 2; ++k) \
        acc[ai][bj][m][n] = __builtin_amdgcn_mfma_f32_16x16x32_bf16(Bt[n][k], At[m][k], acc[ai][bj][m][n], 0, 0, 0); __builtin_amdgcn_s_setprio(0); } while (0)
#define PG8_WAIT_V(n) asm volatile("s_waitcnt vmcnt(" #n ")" ::: "memory")
#define PG8_WAIT_L(n) asm volatile("s_waitcnt lgkmcnt(" #n ")" ::: "memory")
#define PG8_BAR __builtin_amdgcn_s_barrier()
#define PG8_SCHED __builtin_amdgcn_sched_barrier(0)
    Unit cur, nxt; int ui = 0;
    if (!S.next(0, cur)) return;
    f32x4 acc[2][2][4][2];
#pragma unroll
    for (int a = 0; a < 2; ++a)
#pragma unroll
        for (int b = 0; b < 2; ++b)
#pragma unroll
            for (int m = 0; m < 4; ++m)
#pragma unroll
                for (int n = 0; n < 2; ++n) acc[a][b][m][n] = (f32x4){0.f, 0.f, 0.f, 0.f};
    bf16x8 At[4][2], B0[2][2], B1[2][2];
    const char* cA = (const char*)g.A + (size_t)cur.pm * tstep; const char* cB = (const char*)g.Bt + (size_t)cur.pn * tstep;
    S.a_ready(cur);
    if constexpr (SP2) {
        PG8_STAGE(PG8_SB(0, 0), cB, voffB); PG8_STAGE(PG8_SB(0, 1), cB + hstep, voffB); PG8_STAGE(PG8_SA(0, 0), cA, voffA); PG8_STAGE(PG8_SA(0, 1), cA + hstep, voffA);
        if (wr == 1) PG8_BAR;
        PG8_WAIT_V(2); PG8_BAR;
        PG8_STAGE(PG8_SB(1, 0), cB + kstep, voffB); PG8_STAGE(PG8_SA(1, 0), cA + kstep, voffA); PG8_STAGE(PG8_SB(1, 1), cB + hstep + kstep, voffB);
        PG8_WAIT_V(6); PG8_BAR;
    } else {
        PG8_STAGE(PG8_SB(0, 0), cB, voffB); PG8_STAGE(PG8_SA(0, 0), cA, voffA); PG8_STAGE(PG8_SB(0, 1), cB + hstep, voffB); PG8_STAGE(PG8_SA(0, 1), cA + hstep, voffA);
        if (wr == 1) PG8_BAR;
        PG8_WAIT_V(4); PG8_BAR;
        PG8_STAGE(PG8_SB(1, 0), cB + kstep, voffB); PG8_STAGE(PG8_SA(1, 0), cA + kstep, voffA); PG8_STAGE(PG8_SB(1, 1), cB + hstep + kstep, voffB);
        PG8_WAIT_V(6); PG8_BAR;
    }
    for (;;) {
        const bool has_next = S.next(ui + 1, nxt);
        const char* nA = has_next ? (const char*)g.A + (size_t)nxt.pm * tstep : cA; const char* nB = has_next ? (const char*)g.Bt + (size_t)nxt.pn * tstep : cB;
#pragma unroll 1
        for (int t = 0; t < nt; t += 2) {
            const bool last = (t == nt - 2);
            const char* a1 = cA + (size_t)(t + 1) * kstep;
            const char* a2 = last ? nA : cA + (size_t)(t + 2) * kstep; const char* b2 = last ? nB : cB + (size_t)(t + 2) * kstep;
            const char* a3 = a2 + kstep; const char* b3 = b2 + kstep;
            if (last && has_next) S.a_ready(nxt);
            if constexpr (SP2) {
            PG8_LDB(B0, 0, 0); PG8_LDB(B1, 0, 1); PG8_SCHED; PG8_LDA(At, 0, 0); PG8_STAGE(PG8_SA(1, 1), a1 + hstep, voffA);
            PG8_WAIT_V(8); PG8_WAIT_L(0); PG8_BAR; PG8_MMA(0, 0, At, B0); PG8_MMA(0, 1, At, B1); PG8_BAR; PG8_SCHED;
            PG8_LDA(At, 0, 1); PG8_STAGE(PG8_SB(0, 0), b2, voffB); PG8_STAGE(PG8_SB(0, 1), b2 + hstep, voffB); PG8_STAGE(PG8_SA(0, 0), a2, voffA);
            PG8_WAIT_V(8); PG8_WAIT_L(0); PG8_BAR; PG8_MMA(1, 0, At, B0); PG8_MMA(1, 1, At, B1); PG8_BAR; PG8_SCHED;
            PG8_LDB(B0, 1, 0); PG8_LDB(B1, 1, 1); PG8_SCHED; PG8_LDA(At, 1, 0); PG8_STAGE(PG8_SA(0, 1), a2 + hstep, voffA);
            PG8_WAIT_V(8); PG8_WAIT_L(0); PG8_BAR; PG8_MMA(0, 0, At, B0); PG8_MMA(0, 1, At, B1); PG8_BAR; PG8_SCHED;
            PG8_LDA(At, 1, 1); PG8_STAGE(PG8_SB(1, 0), b3, voffB); PG8_STAGE(PG8_SB(1, 1), b3 + hstep, voffB); PG8_STAGE(PG8_SA(1, 0), a3, voffA);
            PG8_WAIT_V(8); PG8_WAIT_L(0); PG8_BAR; PG8_MMA(1, 0, At, B0); PG8_MMA(1, 1, At, B1); PG8_BAR; PG8_SCHED;
            } else {
            PG8_LDB(B0, 0, 0); PG8_SCHED; PG8_LDA(At, 0, 0); PG8_STAGE(PG8_SA(1, 1), a1 + hstep, voffA);
            PG8_WAIT_L(8); PG8_BAR; PG8_WAIT_L(0); PG8_MMA(0, 0, At, B0); PG8_BAR; PG8_SCHED;
            PG8_LDB(B1, 0, 1); PG8_STAGE(PG8_SB(0, 0), b2, voffB);
            PG8_BAR; PG8_WAIT_L(0); PG8_MMA(0, 1, At, B1); PG8_BAR;
            PG8_LDA(At, 0, 1); PG8_STAGE(PG8_SA(0, 0), a2, voffA);
            PG8_BAR; PG8_WAIT_L(0); PG8_MMA(1, 0, At, B0); PG8_BAR; PG8_SCHED;
            PG8_STAGE(PG8_SB(0, 1), b2 + hstep, voffB);
            PG8_WAIT_V(6); PG8_BAR; PG8_MMA(1, 1, At, B1); PG8_BAR;
            PG8_LDB(B0, 1, 0); PG8_SCHED; PG8_LDA(At, 1, 0); PG8_STAGE(PG8_SA(0, 1), a2 + hstep, voffA);
            PG8_WAIT_L(8); PG8_BAR; PG8_WAIT_L(0); PG8_MMA(0, 0, At, B0); PG8_BAR; PG8_SCHED;
            PG8_LDB(B1, 1, 1); PG8_STAGE(PG8_SB(1, 0), b3, voffB);
            PG8_BAR; PG8_WAIT_L(0); PG8_MMA(0, 1, At, B1); PG8_BAR;
            PG8_LDA(At, 1, 1); PG8_STAGE(PG8_SA(1, 0), a3, voffA);
            PG8_BAR; PG8_WAIT_L(0); PG8_MMA(1, 0, At, B0); PG8_BAR; PG8_SCHED;
            PG8_STAGE(PG8_SB(1, 1), b3 + hstep, voffB);
            PG8_WAIT_V(6); PG8_BAR; PG8_MMA(1, 1, At, B1); PG8_BAR;
            }
        }
        if constexpr (ALIGN_EPI) { if (wr == 0) PG8_BAR; }
        if constexpr (!Epi::AFTER_DRAIN) { E(acc, cur, wr, wc, fr, fq); S.done(cur); }
        if (!has_next) break;
#pragma unroll
        for (int a = 0; a < 2; ++a)
#pragma unroll
            for (int b = 0; b < 2; ++b)
#pragma unroll
                for (int m = 0; m < 4; ++m)
#pragma unroll
                    for (int n = 0; n < 2; ++n) acc[a][b][m][n] = (f32x4){0.f, 0.f, 0.f, 0.f};
        cur = nxt; cA = nA; cB = nB; ++ui;
        if constexpr (ALIGN_EPI) { if (wr == 1) PG8_BAR; }
    }
    PG8_WAIT_V(0);
    if constexpr (!ALIGN_EPI) { if (wr == 0) PG8_BAR; }
    PG8_BAR;
    if constexpr (Epi::AFTER_DRAIN) { E.fused(acc, cur, wr, wc, fr, fq, lds, wid, lane); S.done(cur); }
#undef PG8_SA
#undef PG8_SB
#undef PG8_STAGE
#undef PG8_LDA
#undef PG8_LDB
#undef PG8_MMA
#undef PG8_WAIT_V
#undef PG8_WAIT_L
#undef PG8_BAR
#undef PG8_SCHED
}
}


template <class E> struct EpiAdapt {
    static constexpr bool PERM = true, AFTER_DRAIN = false;
    E e;
    template <int I> __device__ __forceinline__ void one(const pg8::f32x4 (&acc)[2][2][4][2], int rowb, int colb) const {
        constexpr int ai = I / 8, m = (I / 2) % 4, bj = I % 2;
        const pg8::f32x4 a0 = acc[ai][bj][m][0], a1 = acc[ai][bj][m][1];
        float v[8] = {a0[0], a0[1], a0[2], a0[3], a1[0], a1[1], a1[2], a1[3]};
        e.apply8(rowb + ai * 128 + m * 16, colb + bj * 128, v);
        asm volatile("" ::: "memory");
    }
    template <int... I> __device__ __forceinline__ void all(std::integer_sequence<int, I...>, const pg8::f32x4 (&acc)[2][2][4][2], int rowb, int colb) const { (one<I>(acc, rowb, colb), ...); }
    __device__ __forceinline__ void operator()(const pg8::f32x4 (&acc)[2][2][4][2], const pg8::Unit& u, int wr, int wc, int fr, int fq) const {
        all(std::make_integer_sequence<int, 16>{}, acc, u.pm * 256 + wr * 64 + fr, u.pn * 256 + wc * 32 + 8 * fq);
    }
};

constexpr int NWAVES = 8, NTHR = 512;
constexpr int RING_OFF = 0, RING_BYTES = 131072;
constexpr int LDSCTL_OFF = RING_BYTES, MISC_OFF = LDSCTL_OFF + 320;
constexpr int LDS_BYTES = 147456;
constexpr int CW_BAR = 4096;
#define LAS __attribute__((address_space(3)))
#define LDS_WAIT() asm volatile("s_waitcnt lgkmcnt(0)" ::: "memory")
#define VM_WAIT() asm volatile("s_waitcnt vmcnt(0)" ::: "memory")

#define XB_TMO      128
#define XB_XCNT(j)  (256  + 64 * (j))
#define XB_XSUB(j)  (1280 + 64 * (j))
#define XB_XGEN(j)  (2304 + 64 * (j))
#define XB_TOP      3328
#define XB_TOPGEN   3392
#define XCD_BAR_WORDS 3456
#define XB_SPIN_CAP (1u << 18)

__device__ __forceinline__ unsigned xb_ld(unsigned* p)              { return __hip_atomic_load(p, __ATOMIC_RELAXED, __HIP_MEMORY_SCOPE_AGENT); }
__device__ __forceinline__ unsigned xb_add(unsigned* p, unsigned v) { return __hip_atomic_fetch_add(p, v, __ATOMIC_RELAXED, __HIP_MEMORY_SCOPE_AGENT); }
__device__ __forceinline__ unsigned xb_xcc_id() { return (unsigned)__builtin_amdgcn_s_getreg((3 << 11) | 20) & 0xFu; }
#define XB_SPIN(cond, bar) do { unsigned _sp = 0; while (cond) { __builtin_amdgcn_s_sleep(1); \
    if ((++_sp & 255u) == 0u) { if (xb_ld(&(bar)[XB_TMO])) break; if (_sp > XB_SPIN_CAP) { atomicAdd(&(bar)[XB_TMO], 1u); break; } } } } while (0)

struct XcdBarrier {
    unsigned* bar; unsigned x;
    volatile LAS unsigned* st;
};

__device__ __forceinline__ XcdBarrier xcd_barrier_post(unsigned* bar, volatile LAS unsigned* st) {
    XcdBarrier b; b.bar = bar; b.x = xb_xcc_id(); b.st = st;
    if (threadIdx.x == 0) (void)xb_add(&bar[XB_XCNT(b.x)], 1u);
    return b;
}
__device__ __forceinline__ void xcd_barrier_complete(unsigned* bar, unsigned x, unsigned& nloc, unsigned& nx) {
    const unsigned G = gridDim.x * gridDim.y * gridDim.z;
    unsigned sum, cnt, mine, sp = 0u;
    for (;;) {
        sum = 0u; cnt = 0u; mine = 0u;
#pragma unroll
        for (unsigned j = 0; j < 16; ++j) { const unsigned c = xb_ld(&bar[XB_XCNT(j)]); sum += c; cnt += (c > 0u) ? 1u : 0u; mine = (j == x) ? c : mine; }
        if (sum == G) break;
        __builtin_amdgcn_s_sleep(1);
        if ((++sp & 255u) == 0u) { if (xb_ld(&bar[XB_TMO])) break; if (sp > XB_SPIN_CAP) { atomicAdd(&bar[XB_TMO], 1u); break; } }
    }
    nloc = mine > 0u ? mine : 1u; nx = cnt > 0u ? cnt : 1u;
}

__device__ __forceinline__ void xcd_barrier(const XcdBarrier& b) {
    asm volatile("s_waitcnt vmcnt(0)" ::: "memory");
    __syncthreads();
    if (threadIdx.x == 0) {
        unsigned* bar = b.bar;
        __builtin_amdgcn_s_waitcnt(0);
        unsigned nloc = b.st[0], nx = b.st[1];
        if (nloc == 0u) { xcd_barrier_complete(bar, b.x, nloc, nx); b.st[0] = nloc; b.st[1] = nx; }
        const unsigned old = xb_add(&bar[XB_XSUB(b.x)], 1u);
        const unsigned gen = old / nloc;
        if (old + 1u == (gen + 1u) * nloc) {
            __builtin_amdgcn_fence(__ATOMIC_RELEASE, "agent");
            asm volatile("s_waitcnt vmcnt(0)" ::: "memory");
            const unsigned og = xb_add(&bar[XB_TOP], 1u);
            const unsigned tg = og / nx;
            if (og + 1u == (tg + 1u) * nx) xb_add(&bar[XB_TOPGEN], 1u);
            else XB_SPIN(xb_ld(&bar[XB_TOPGEN]) == tg, bar);
            __builtin_amdgcn_fence(__ATOMIC_ACQUIRE, "agent");
            xb_add(&bar[XB_XGEN(b.x)], 1u);
            asm volatile("s_waitcnt vmcnt(0)" ::: "memory");
        } else {
            XB_SPIN(xb_ld(&bar[XB_XGEN(b.x)]) == gen, bar);
            __builtin_amdgcn_fence(__ATOMIC_ACQUIRE, "agent");
            asm volatile("s_waitcnt vmcnt(0)" ::: "memory");
        }
    }
    __syncthreads();
}


static_assert((CW_BAR + 8 * XCD_BAR_WORDS) * 4 <= (int)CTL_SS2, "barrier regions below the accumulators");

enum Phase { PH_PRO = 0, PH_GEMM1, PH_RWSHIFT, PH_LORA, PH_HGRN, PH_RWKV, PH_RWPOST, PH_BR, PH_OUT, PH_QG, PH_TOPK, PH_GU, PH_GV, PH_PLE, PH_FINAL, PH_N };

struct Args { const float* in[29]; float* out; unsigned char* ws; int ph_lo, ph_hi, li, pad; };

struct Frame {
    LAS unsigned char* lds;
    int tid, lane, wave, vcu, G;
};

__device__ __forceinline__ void tr_item(const float* W, const float* sk, int K, int N, bf16* WT, int ldk, int koff, int row_off, LAS float* scr, int item, int lane) {
    const int nblk = N / 32, kb = item / nblk, nb = item % nblk, k0 = 64 * kb, n0 = 32 * nb;
#pragma unroll 8
    for (int i = 0; i < 32; ++i) { const int kk = 2 * i + (lane >> 5); float v = W[(size_t)(k0 + kk) * N + n0 + (lane & 31)]; if (sk) v *= sk[k0 + kk]; scr[kk * 33 + (lane & 31)] = v; }
    LDS_WAIT(); asm volatile("" ::: "memory");
    const int c = lane & 7;
#pragma unroll
    for (int j = 0; j < 4; ++j) { const int n = (lane >> 3) + 8 * j; const LAS float* s = scr + (8 * c) * 33 + n;
        v4u o; o.x = pk2(s[0 * 33], s[1 * 33]); o.y = pk2(s[2 * 33], s[3 * 33]); o.z = pk2(s[4 * 33], s[5 * 33]); o.w = pk2(s[6 * 33], s[7 * 33]);
        *(v4u*)(WT + (size_t)(row_off + n0 + n) * ldk + koff + k0 + 8 * c) = o; }
    LDS_WAIT(); asm volatile("" ::: "memory");
}

__device__ __forceinline__ void xprep_row(const float* x, bf16* xb, float* r1, int row, int lane) {
    const f32x4* xr = (const f32x4*)(x + (size_t)row * D) + lane;
    f32x4 v[4]; float s = 0.f;
#pragma unroll
    for (int j = 0; j < 4; ++j) { v[j] = xr[64 * j]; s += (v[j].x * v[j].x + v[j].y * v[j].y) + (v[j].z * v[j].z + v[j].w * v[j].w); }
    s = wave_sum(s);
    if (lane == 0) r1[row] = rsqrtf(s * (1.f / D) + RMS_EPS);
    v2u* o = (v2u*)(xb + (size_t)row * D) + lane;
#pragma unroll
    for (int j = 0; j < 4; ++j) { v2u w; w.x = pk2(v[j].x, v[j].y); w.y = pk2(v[j].z, v[j].w); o[64 * j] = w; }
}

template <int CTRL> __device__ __forceinline__ float dppf(float x) { return __builtin_bit_cast(float, __builtin_amdgcn_update_dpp(0, __builtin_bit_cast(int, x), CTRL, 0xf, 0xf, true)); }
__device__ __forceinline__ float red8(float x) { x += dppf<0xB1>(x); x += dppf<0x4E>(x); x += dppf<0x141>(x); return x; }
__device__ __forceinline__ float red16(float x) { x = red8(x); x += dppf<0x140>(x); return x; }
__device__ __forceinline__ float red32(float x) {
    x = red16(x);
    auto sw = __builtin_amdgcn_permlane16_swap(__float_as_uint(x), __float_as_uint(x), false, false);
    return __uint_as_float(sw[0]) + __uint_as_float(sw[1]);
}

__device__ __forceinline__ void red32x2(float& a, float& b) {
    a += dppf<0xB1>(a); b += dppf<0xB1>(b);
    a += dppf<0x4E>(a); b += dppf<0x4E>(b);
    a += dppf<0x141>(a); b += dppf<0x141>(b);
    a += dppf<0x140>(a); b += dppf<0x140>(b);
    auto sa = __builtin_amdgcn_permlane16_swap(__float_as_uint(a), __float_as_uint(a), false, false);
    auto sb = __builtin_amdgcn_permlane16_swap(__float_as_uint(b), __float_as_uint(b), false, false);
    a = __uint_as_float(sa[0]) + __uint_as_float(sa[1]); b = __uint_as_float(sb[0]) + __uint_as_float(sb[1]);
}
constexpr int RW_CH = 64;
constexpr int RW_REC = 6 * 64;
__device__ __forceinline__ void rwkv_item(Frame& F, int item, const bf16* R, const bf16* Kk, const bf16* V, const bf16* LW, const bf16* A, const float* k_k, const float* k_a, const float* r_k,
                                          bf16* yraw, float* bonus) {
    LAS float* REC = (LAS float*)(F.lds + RING_OFF);
    LAS float* YS = REC + RW_CH * RW_REC;
    const int pair = item >> 2, rq = item & 3, b = pair / RWH, h = pair % RWH;
    const int tid = F.tid, tk = tid >> 3, c8 = (tid & 7) * 8;
    const int row = tid >> 5, kp = tid & 31;
    float ckk[8], cka[8], crk[8];
#pragma unroll
    for (int j = 0; j < 8; ++j) { ckk[j] = k_k[h * 64 + c8 + j]; cka[j] = k_a[h * 64 + c8 + j]; crk[j] = r_k[h * 64 + c8 + j]; }
    float S0 = 0.f, S1 = 0.f;
    const size_t gbase = ((size_t)b * SEQ + tk) * 512 + h * 64 + c8;
    v4u rr, rk, rv, ra, rl;
    rr = *(const v4u*)(R + gbase); rk = *(const v4u*)(Kk + gbase); rv = *(const v4u*)(V + gbase); ra = *(const v4u*)(A + gbase); rl = *(const v4u*)(LW + gbase);
    for (int c = 0; c < SEQ / RW_CH; ++c) {
        {
            float fr[8], fk[8], fv[8], fa[8], fl[8], kk[8], k2[8], o[8];
            unpack8(rr, fr); unpack8(rk, fk); unpack8(rv, fv); unpack8(ra, fa); unpack8(rl, fl);
            float n2 = 0.f, bs = 0.f;
#pragma unroll
            for (int j = 0; j < 8; ++j) { kk[j] = fk[j] * ckk[j]; n2 += kk[j] * kk[j]; k2[j] = fk[j] * (1.f + (fa[j] - 1.f) * cka[j]); bs += fr[j] * k2[j] * crk[j]; }
            n2 = red8(n2); bs = red8(bs);
            const float inv = 1.f / fmaxf(sqrtf(n2), 1e-12f);
            LAS float* rec = REC + tk * RW_REC + c8;
#pragma unroll
            for (int j = 0; j < 8; ++j) kk[j] *= inv;
            *(LAS f32x4*)(rec + 0 * 64) = (f32x4){kk[0], kk[1], kk[2], kk[3]}; *(LAS f32x4*)(rec + 0 * 64 + 4) = (f32x4){kk[4], kk[5], kk[6], kk[7]};
#pragma unroll
            for (int j = 0; j < 8; ++j) o[j] = __expf(fl[j]);
            *(LAS f32x4*)(rec + 1 * 64) = (f32x4){o[0], o[1], o[2], o[3]}; *(LAS f32x4*)(rec + 1 * 64 + 4) = (f32x4){o[4], o[5], o[6], o[7]};
#pragma unroll
            for (int j = 0; j < 8; ++j) o[j] = kk[j] * fa[j];
            *(LAS f32x4*)(rec + 2 * 64) = (f32x4){o[0], o[1], o[2], o[3]}; *(LAS f32x4*)(rec + 2 * 64 + 4) = (f32x4){o[4], o[5], o[6], o[7]};
            *(LAS f32x4*)(rec + 3 * 64) = (f32x4){k2[0], k2[1], k2[2], k2[3]}; *(LAS f32x4*)(rec + 3 * 64 + 4) = (f32x4){k2[4], k2[5], k2[6], k2[7]};
            *(LAS f32x4*)(rec + 4 * 64) = (f32x4){fr[0], fr[1], fr[2], fr[3]}; *(LAS f32x4*)(rec + 4 * 64 + 4) = (f32x4){fr[4], fr[5], fr[6], fr[7]};
            *(LAS f32x4*)(rec + 5 * 64) = (f32x4){fv[0], fv[1], fv[2], fv[3]}; *(LAS f32x4*)(rec + 5 * 64 + 4) = (f32x4){fv[4], fv[5], fv[6], fv[7]};
            if (rq == 0 && (tid & 7) == 0) bonus[((size_t)b * SEQ + c * RW_CH + tk) * 8 + h] = bs;
        }
        __syncthreads();
        if (c + 1 < SEQ / RW_CH) { const size_t g2 = gbase + (size_t)(c + 1) * RW_CH * 512;
            rr = *(const v4u*)(R + g2); rk = *(const v4u*)(Kk + g2); rv = *(const v4u*)(V + g2); ra = *(const v4u*)(A + g2); rl = *(const v4u*)(LW + g2); }
        {
            const LAS float* rp = REC + 2 * kp; const LAS float* vp = REC + 320 + rq * 16 + row;
            f32x2 kk2 = *(const LAS f32x2*)(rp), w2 = *(const LAS f32x2*)(rp + 64), ab2 = *(const LAS f32x2*)(rp + 128), k22 = *(const LAS f32x2*)(rp + 192), r2 = *(const LAS f32x2*)(rp + 256);
            float vv = *vp;
#pragma unroll 1
            for (int tb = 0; tb < RW_CH / 32; ++tb) {
                float ykeep = 0.f, yp = 0.f;
#pragma unroll
                for (int ti = 0; ti < 32; ++ti) {
                    const int tn = (tb * 32 + ti + 1) & (RW_CH - 1);
                    const LAS float* rn = rp + tn * RW_REC;
                    const f32x2 kk2n = *(const LAS f32x2*)(rn), w2n = *(const LAS f32x2*)(rn + 64), ab2n = *(const LAS f32x2*)(rn + 128), k22n = *(const LAS f32x2*)(rn + 192), r2n = *(const LAS f32x2*)(rn + 256);
                    const float vvn = vp[tn * RW_REC];
                    float sa = S0 * kk2.x + S1 * kk2.y, yr = yp;
                    red32x2(sa, yr);
                    if (ti > 0) ykeep = (kp == ti - 1) ? yr : ykeep;
                    S0 = S0 * w2.x - sa * ab2.x + vv * k22.x; S1 = S1 * w2.y - sa * ab2.y + vv * k22.y;
                    yp = S0 * r2.x + S1 * r2.y;
                    kk2 = kk2n; w2 = w2n; ab2 = ab2n; k22 = k22n; r2 = r2n; vv = vvn;
                }
                { const float yl = red32(yp); ykeep = (kp == 31) ? yl : ykeep; }
                YS[(tb * 32 + kp) * 16 + row] = ykeep;
            }
        }
        __syncthreads();
        if (tid < 128) { const int t2 = tid >> 1, hf = tid & 1; const LAS float* ys = YS + t2 * 16 + hf * 8;
            float o[8];
#pragma unroll
            for (int j = 0; j < 8; ++j) o[j] = ys[j];
            *(v4u*)(yraw + ((size_t)b * SEQ + c * RW_CH + t2) * 512 + h * 64 + rq * 16 + hf * 8) = pack8(o); }
    }
    __syncthreads();
}

typedef short bf16x8 __attribute__((ext_vector_type(8)));
constexpr int HQ_LD = 136, HT_LD = 72;
constexpr int HL_Q = 0, HL_K = 17408, HL_KHT = 34816, HL_VT = 53248, HL_ATT = 71680, HL_ST = 80896, HL_D = 115712, HL_QT = 116224, HL_RS = 118272;
__device__ __forceinline__ bf16x8 ldfrag(const LAS bf16* base, int ld, int row0, int k0, int lane) { return *(const LAS bf16x8*)(base + (row0 + (lane & 15)) * ld + k0 + 8 * (lane >> 4)); }
template <bool OUT> __device__ __forceinline__ void hgrn_unit(Frame& F, int u, const bf16* cq, const float* nw, bf16* yhg, float* hst, float* hd) {
    LAS bf16* Qs = (LAS bf16*)(F.lds + HL_Q); LAS bf16* Ks = (LAS bf16*)(F.lds + HL_K); LAS bf16* KhT = (LAS bf16*)(F.lds + HL_KHT); LAS bf16* VT = (LAS bf16*)(F.lds + HL_VT);
    LAS bf16* ATT = (LAS bf16*)(F.lds + HL_ATT); LAS bf16* ST = (LAS bf16*)(F.lds + HL_ST); LAS bf16* OT = Ks;
    LAS float* Ds = (LAS float*)(F.lds + HL_D); LAS float* QT = (LAS float*)(F.lds + HL_QT); LAS float* RS = (LAS float*)(F.lds + HL_RS);
    const int b = u >> 5, h = (u >> 3) & 3, sc = u & 7;
    const int tid = F.tid, lane = F.lane, w = F.wave, c = tid & 127, tq = tid >> 7, lr = lane & 15, lq = lane >> 4;
    f32x4 S[8];
#pragma unroll
    for (int j = 0; j < 8; ++j) S[j] = (f32x4){0.f, 0.f, 0.f, 0.f};
    float btot = 0.f;
    if (OUT) {
        for (int j = 0; j < sc; ++j) {
            const int uj = (u & ~7) + j; const float* N = hst + ((size_t)uj * 8 + w) * 32 * 64; const float* Dj = hd + (size_t)uj * 128;
#pragma unroll
            for (int tc = 0; tc < 8; ++tc) { const float d = Dj[tc * 16 + lr];
#pragma unroll
                for (int r = 0; r < 4; ++r) S[tc][r] = S[tc][r] * d + N[(tc * 4 + r) * 64 + lane]; }
        }
#pragma unroll
        for (int tc = 0; tc < 8; ++tc)
#pragma unroll
            for (int r = 0; r < 4; ++r) ST[(w * 16 + 4 * lq + r) * HQ_LD + tc * 16 + lr] = (bf16)f2bf(S[tc][r]);
    }
    for (int ch = 0; ch < 4; ++ch) {
        const size_t tok0 = (size_t)b * SEQ + sc * 256 + ch * 64;
        {
            const bf16* base = cq + (tok0 + tq * 16) * 2048 + h * 128 + c;
            float g[16], bl[16], vv[16], qq[16];
#pragma unroll
            for (int i = 0; i < 16; ++i) { g[i] = bf2f(base[(size_t)i * 2048 + 512]); vv[i] = bf2f(base[(size_t)i * 2048 + 1024]); if (OUT) qq[i] = bf2f(base[(size_t)i * 2048]); }
            float run = 0.f;
#pragma unroll
            for (int i = 0; i < 16; ++i) { run += g[i]; bl[i] = run; }
            QT[tq * 128 + c] = run;
            __syncthreads();
            float off = 0.f, tot = 0.f;
#pragma unroll
            for (int j = 0; j < 4; ++j) { const float x = QT[j * 128 + c]; tot += x; if (j < tq) off += x; }
            float kh[16];
#pragma unroll
            for (int i = 0; i < 16; ++i) {
                const float bb = off + bl[i], k = 1.f - __expf(g[i]);
                kh[i] = k * __expf(tot - bb);
                if (OUT) { Qs[(tq * 16 + i) * HQ_LD + c] = (bf16)f2bf(qq[i] * __expf(bb)); Ks[(tq * 16 + i) * HQ_LD + c] = (bf16)f2bf(k * __expf(-bb)); }
            }
            v4u p0, p1;
            p0.x = pk2(kh[0], kh[1]); p0.y = pk2(kh[2], kh[3]); p0.z = pk2(kh[4], kh[5]); p0.w = pk2(kh[6], kh[7]); p1.x = pk2(kh[8], kh[9]); p1.y = pk2(kh[10], kh[11]); p1.z = pk2(kh[12], kh[13]); p1.w = pk2(kh[14], kh[15]);
            *(LAS v4u*)(KhT + c * HT_LD + tq * 16) = p0; *(LAS v4u*)(KhT + c * HT_LD + tq * 16 + 8) = p1;
            p0.x = pk2(vv[0], vv[1]); p0.y = pk2(vv[2], vv[3]); p0.z = pk2(vv[4], vv[5]); p0.w = pk2(vv[6], vv[7]); p1.x = pk2(vv[8], vv[9]); p1.y = pk2(vv[10], vv[11]); p1.z = pk2(vv[12], vv[13]); p1.w = pk2(vv[14], vv[15]);
            *(LAS v4u*)(VT + c * HT_LD + tq * 16) = p0; *(LAS v4u*)(VT + c * HT_LD + tq * 16 + 8) = p1;
            if (tq == 0) Ds[c] = __expf(tot);
            btot += tot;
        }
        __syncthreads();
        if (OUT) {
            {
                const int tr = w >> 1;
#pragma unroll
                for (int j = 0; j < 2; ++j) { const int tc = (w & 1) * 2 + j;
                    f32x4 a4 = (f32x4){0.f, 0.f, 0.f, 0.f};
                    if (tc <= tr) {
#pragma unroll
                        for (int ks = 0; ks < 4; ++ks) a4 = __builtin_amdgcn_mfma_f32_16x16x32_bf16(ldfrag(Qs, HQ_LD, tr * 16, ks * 32, lane), ldfrag(Ks, HQ_LD, tc * 16, ks * 32, lane), a4, 0, 0, 0);
                    }
#pragma unroll
                    for (int r = 0; r < 4; ++r) { const int t = tr * 16 + 4 * lq + r, s2 = tc * 16 + lr; ATT[t * HT_LD + s2] = (bf16)f2bf(s2 <= t ? a4[r] : 0.f); }
                }
            }
            __syncthreads();
            f32x4 o4[4];
            {
                const int tr = w >> 1;
#pragma unroll
                for (int j = 0; j < 4; ++j) { const int tc = (w & 1) * 4 + j; f32x4 a4 = (f32x4){0.f, 0.f, 0.f, 0.f};
#pragma unroll
                    for (int ks = 0; ks < 2; ++ks) a4 = __builtin_amdgcn_mfma_f32_16x16x32_bf16(ldfrag(ATT, HT_LD, tr * 16, ks * 32, lane), ldfrag(VT, HT_LD, tc * 16, ks * 32, lane), a4, 0, 0, 0);
#pragma unroll
                    for (int ks = 0; ks < 4; ++ks) a4 = __builtin_amdgcn_mfma_f32_16x16x32_bf16(ldfrag(Qs, HQ_LD, tr * 16, ks * 32, lane), ldfrag(ST, HQ_LD, tc * 16, ks * 32, lane), a4, 0, 0, 0);
                    o4[j] = a4; }
#pragma unroll
                for (int r = 0; r < 4; ++r) { float p = o4[0][r] * o4[0][r] + o4[1][r] * o4[1][r] + o4[2][r] * o4[2][r] + o4[3][r] * o4[3][r]; p = red16(p);
                    if (lr == 0) RS[(tr * 16 + 4 * lq + r) * 2 + (w & 1)] = p; }
            }
            __syncthreads();
            {
                const int tr = w >> 1;
#pragma unroll
                for (int r = 0; r < 4; ++r) { const int t = tr * 16 + 4 * lq + r; const float rs = rsqrtf((RS[t * 2] + RS[t * 2 + 1]) * (1.f / 128.f) + RMS_EPS);
#pragma unroll
                    for (int j = 0; j < 4; ++j) OT[t * HQ_LD + ((w & 1) * 4 + j) * 16 + lr] = (bf16)f2bf(o4[j][r] * rs); }
            }
        }
#pragma unroll
        for (int tc = 0; tc < 8; ++tc) { const float d = Ds[tc * 16 + lr]; f32x4 a4 = S[tc] * d;
#pragma unroll
            for (int ks = 0; ks < 2; ++ks) a4 = __builtin_amdgcn_mfma_f32_16x16x32_bf16(ldfrag(VT, HT_LD, w * 16, ks * 32, lane), ldfrag(KhT, HT_LD, tc * 16, ks * 32, lane), a4, 0, 0, 0);
            S[tc] = a4; }
        if (OUT) {
#pragma unroll
            for (int tc = 0; tc < 8; ++tc)
#pragma unroll
                for (int r = 0; r < 4; ++r) ST[(w * 16 + 4 * lq + r) * HQ_LD + tc * 16 + lr] = (bf16)f2bf(S[tc][r]);
        }
        __syncthreads();
        if (OUT) {
#pragma unroll
            for (int i = 0; i < 2; ++i) { const int id = tid + 512 * i, t = id >> 4, c8 = (id & 15) * 8;
                float ot[8], go[8], y[8];
                unpack8(*(const LAS v4u*)(OT + t * HQ_LD + c8), ot); unpack8(*(const v4u*)(cq + (tok0 + t) * 2048 + 1536 + h * 128 + c8), go);
#pragma unroll
                for (int j = 0; j < 8; ++j) y[j] = ot[j] * nw[h * 128 + c8 + j] * go[j];
                *(v4u*)(yhg + (tok0 + t) * 512 + h * 128 + c8) = pack8(y); }
        }
    }
    if (!OUT) {
        float* N = hst + ((size_t)u * 8 + w) * 32 * 64;
#pragma unroll
        for (int tc = 0; tc < 8; ++tc)
#pragma unroll
            for (int r = 0; r < 4; ++r) N[(tc * 4 + r) * 64 + lane] = S[tc][r];
        if (tq == 0) hd[(size_t)u * 128 + c] = __expf(btot);
    }
    __syncthreads();
}

#define CE_(a, b) { const float hi_ = fmaxf(a, b), lo_ = fminf(a, b); a = hi_; b = lo_; }
__device__ __forceinline__ void sort16_desc(float (&x)[16]) {
    CE_(x[0], x[1]) CE_(x[3], x[2]) CE_(x[4], x[5]) CE_(x[7], x[6]) CE_(x[8], x[9]) CE_(x[11], x[10]) CE_(x[12], x[13]) CE_(x[15], x[14]) CE_(x[0], x[2]) CE_(x[1], x[3]) CE_(x[6], x[4]) CE_(x[7], x[5]) CE_(x[8], x[10]) CE_(x[9], x[11]) CE_(x[14], x[12]) CE_(x[15], x[13]) CE_(x[0], x[1]) CE_(x[2], x[3]) CE_(x[5], x[4]) CE_(x[7], x[6]) CE_(x[8], x[9]) CE_(x[10], x[11]) CE_(x[13], x[12]) CE_(x[15], x[14]) CE_(x[0], x[4]) CE_(x[1], x[5]) CE_(x[2], x[6]) CE_(x[3], x[7]) CE_(x[12], x[8]) CE_(x[13], x[9]) CE_(x[14], x[10]) CE_(x[15], x[11]) CE_(x[0], x[2]) CE_(x[1], x[3]) CE_(x[4], x[6]) CE_(x[5], x[7]) CE_(x[10], x[8]) CE_(x[11], x[9]) CE_(x[14], x[12]) CE_(x[15], x[13]) CE_(x[0], x[1]) CE_(x[2], x[3]) CE_(x[4], x[5]) CE_(x[6], x[7]) CE_(x[9], x[8]) CE_(x[11], x[10]) CE_(x[13], x[12]) CE_(x[15], x[14]) CE_(x[0], x[8]) CE_(x[1], x[9]) CE_(x[2], x[10]) CE_(x[3], x[11]) CE_(x[4], x[12]) CE_(x[5], x[13]) CE_(x[6], x[14]) CE_(x[7], x[15]) CE_(x[0], x[4]) CE_(x[1], x[5]) CE_(x[2], x[6]) CE_(x[3], x[7]) CE_(x[8], x[12]) CE_(x[9], x[13]) CE_(x[10], x[14]) CE_(x[11], x[15]) CE_(x[0], x[2]) CE_(x[1], x[3]) CE_(x[4], x[6]) CE_(x[5], x[7]) CE_(x[8], x[10]) CE_(x[9], x[11]) CE_(x[12], x[14]) CE_(x[13], x[15]) CE_(x[0], x[1]) CE_(x[2], x[3]) CE_(x[4], x[5]) CE_(x[6], x[7]) CE_(x[8], x[9]) CE_(x[10], x[11]) CE_(x[12], x[13]) CE_(x[14], x[15])
}
__device__ __forceinline__ void merge16_desc(float (&a)[16], const float (&b)[16]) {
    a[0] = fmaxf(a[0], b[15]); a[1] = fmaxf(a[1], b[14]); a[2] = fmaxf(a[2], b[13]); a[3] = fmaxf(a[3], b[12]); a[4] = fmaxf(a[4], b[11]); a[5] = fmaxf(a[5], b[10]); a[6] = fmaxf(a[6], b[9]); a[7] = fmaxf(a[7], b[8]); a[8] = fmaxf(a[8], b[7]); a[9] = fmaxf(a[9], b[6]); a[10] = fmaxf(a[10], b[5]); a[11] = fmaxf(a[11], b[4]); a[12] = fmaxf(a[12], b[3]); a[13] = fmaxf(a[13], b[2]); a[14] = fmaxf(a[14], b[1]); a[15] = fmaxf(a[15], b[0]);
    CE_(a[0], a[8]) CE_(a[1], a[9]) CE_(a[2], a[10]) CE_(a[3], a[11]) CE_(a[4], a[12]) CE_(a[5], a[13]) CE_(a[6], a[14]) CE_(a[7], a[15]) CE_(a[0], a[4]) CE_(a[1], a[5]) CE_(a[2], a[6]) CE_(a[3], a[7]) CE_(a[8], a[12]) CE_(a[9], a[13]) CE_(a[10], a[14]) CE_(a[11], a[15]) CE_(a[0], a[2]) CE_(a[1], a[3]) CE_(a[4], a[6]) CE_(a[5], a[7]) CE_(a[8], a[10]) CE_(a[9], a[11]) CE_(a[12], a[14]) CE_(a[13], a[15]) CE_(a[0], a[1]) CE_(a[2], a[3]) CE_(a[4], a[5]) CE_(a[6], a[7]) CE_(a[8], a[9]) CE_(a[10], a[11]) CE_(a[12], a[13]) CE_(a[14], a[15])
}

__device__ __forceinline__ void cand_lists(const float (&s0)[16], const float (&s1)[16], bool hh, float (&ca)[16], float (&cb)[16]) {
    { const float v = hh ? (s0[2] + s1[1]) : (s0[0] + s1[0]); const unsigned cd = hh ? 222u : 255u; ca[0] = __builtin_bit_cast(float, (__builtin_bit_cast(unsigned, v) & 0xFFFFFF00u) | cd); }
    { const float v = hh ? (s0[2] + s1[2]) : (s0[0] + s1[1]); const unsigned cd = hh ? 221u : 254u; ca[1] = __builtin_bit_cast(float, (__builtin_bit_cast(unsigned, v) & 0xFFFFFF00u) | cd); }
    { const float v = hh ? (s0[2] + s1[3]) : (s0[0] + s1[2]); const unsigned cd = hh ? 220u : 253u; ca[2] = __builtin_bit_cast(float, (__builtin_bit_cast(unsigned, v) & 0xFFFFFF00u) | cd); }
    { const float v = hh ? (s0[2] + s1[4]) : (s0[0] + s1[3]); const unsigned cd = hh ? 219u : 252u; ca[3] = __builtin_bit_cast(float, (__builtin_bit_cast(unsigned, v) & 0xFFFFFF00u) | cd); }
    { const float v = hh ? (s0[3] + s1[0]) : (s0[0] + s1[4]); const unsigned cd = hh ? 207u : 251u; ca[4] = __builtin_bit_cast(float, (__builtin_bit_cast(unsigned, v) & 0xFFFFFF00u) | cd); }
    { const float v = hh ? (s0[3] + s1[1]) : (s0[0] + s1[5]); const unsigned cd = hh ? 206u : 250u; ca[5] = __builtin_bit_cast(float, (__builtin_bit_cast(unsigned, v) & 0xFFFFFF00u) | cd); }
    { const float v = hh ? (s0[3] + s1[2]) : (s0[0] + s1[6]); const unsigned cd = hh ? 205u : 249u; ca[6] = __builtin_bit_cast(float, (__builtin_bit_cast(unsigned, v) & 0xFFFFFF00u) | cd); }
    { const float v = hh ? (s0[3] + s1[3]) : (s0[0] + s1[7]); const unsigned cd = hh ? 204u : 248u; ca[7] = __builtin_bit_cast(float, (__builtin_bit_cast(unsigned, v) & 0xFFFFFF00u) | cd); }
    { const float v = hh ? (s0[4] + s1[0]) : (s0[0] + s1[8]); const unsigned cd = hh ? 191u : 247u; ca[8] = __builtin_bit_cast(float, (__builtin_bit_cast(unsigned, v) & 0xFFFFFF00u) | cd); }
    { const float v = hh ? (s0[4] + s1[1]) : (s0[0] + s1[9]); const unsigned cd = hh ? 190u : 246u; ca[9] = __builtin_bit_cast(float, (__builtin_bit_cast(unsigned, v) & 0xFFFFFF00u) | cd); }
    { const float v = hh ? (s0[4] + s1[2]) : (s0[0] + s1[10]); const unsigned cd = hh ? 189u : 245u; ca[10] = __builtin_bit_cast(float, (__builtin_bit_cast(unsigned, v) & 0xFFFFFF00u) | cd); }
    { const float v = hh ? (s0[5] + s1[0]) : (s0[0] + s1[11]); const unsigned cd = hh ? 175u : 244u; ca[11] = __builtin_bit_cast(float, (__builtin_bit_cast(unsigned, v) & 0xFFFFFF00u) | cd); }
    { const float v = hh ? (s0[5] + s1[1]) : (s0[0] + s1[12]); const unsigned cd = hh ? 174u : 243u; ca[12] = __builtin_bit_cast(float, (__builtin_bit_cast(unsigned, v) & 0xFFFFFF00u) | cd); }
    { const float v = hh ? (s0[6] + s1[0]) : (s0[0] + s1[13]); const unsigned cd = hh ? 159u : 242u; ca[13] = __builtin_bit_cast(float, (__builtin_bit_cast(unsigned, v) & 0xFFFFFF00u) | cd); }
    { const float v = hh ? (s0[6] + s1[1]) : (s0[0] + s1[14]); const unsigned cd = hh ? 158u : 241u; ca[14] = __builtin_bit_cast(float, (__builtin_bit_cast(unsigned, v) & 0xFFFFFF00u) | cd); }
    { const float v = hh ? (s0[7] + s1[0]) : (s0[0] + s1[15]); const unsigned cd = hh ? 143u : 240u; ca[15] = __builtin_bit_cast(float, (__builtin_bit_cast(unsigned, v) & 0xFFFFFF00u) | cd); }
    { const float v = hh ? (s0[7] + s1[1]) : (s0[1] + s1[0]); const unsigned cd = hh ? 142u : 239u; cb[0] = __builtin_bit_cast(float, (__builtin_bit_cast(unsigned, v) & 0xFFFFFF00u) | cd); }
    { const float v = hh ? (s0[8] + s1[0]) : (s0[1] + s1[1]); const unsigned cd = hh ? 127u : 238u; cb[1] = __builtin_bit_cast(float, (__builtin_bit_cast(unsigned, v) & 0xFFFFFF00u) | cd); }
    { const float v = hh ? (s0[9] + s1[0]) : (s0[1] + s1[2]); const unsigned cd = hh ? 111u : 237u; cb[2] = __builtin_bit_cast(float, (__builtin_bit_cast(unsigned, v) & 0xFFFFFF00u) | cd); }
    { const float v = hh ? (s0[10] + s1[0]) : (s0[1] + s1[3]); const unsigned cd = hh ? 95u : 236u; cb[3] = __builtin_bit_cast(float, (__builtin_bit_cast(unsigned, v) & 0xFFFFFF00u) | cd); }
    { const float v = hh ? (s0[11] + s1[0]) : (s0[1] + s1[4]); const unsigned cd = hh ? 79u : 235u; cb[4] = __builtin_bit_cast(float, (__builtin_bit_cast(unsigned, v) & 0xFFFFFF00u) | cd); }
    { const float v = hh ? (s0[12] + s1[0]) : (s0[1] + s1[5]); const unsigned cd = hh ? 63u : 234u; cb[5] = __builtin_bit_cast(float, (__builtin_bit_cast(unsigned, v) & 0xFFFFFF00u) | cd); }
    { const float v = hh ? (s0[13] + s1[0]) : (s0[1] + s1[6]); const unsigned cd = hh ? 47u : 233u; cb[6] = __builtin_bit_cast(float, (__builtin_bit_cast(unsigned, v) & 0xFFFFFF00u) | cd); }
    { const float v = hh ? (s0[14] + s1[0]) : (s0[1] + s1[7]); const unsigned cd = hh ? 31u : 232u; cb[7] = __builtin_bit_cast(float, (__builtin_bit_cast(unsigned, v) & 0xFFFFFF00u) | cd); }
    { const float v = hh ? (s0[15] + s1[0]) : (s0[2] + s1[0]); const unsigned cd = hh ? 15u : 223u; cb[8] = __builtin_bit_cast(float, (__builtin_bit_cast(unsigned, v) & 0xFFFFFF00u) | cd); }
    cb[9] = -3.0e38f;
    cb[10] = -3.0e38f;
    cb[11] = -3.0e38f;
    cb[12] = -3.0e38f;
    cb[13] = -3.0e38f;
    cb[14] = -3.0e38f;
    cb[15] = -3.0e38f;
}

typedef float f32x16 __attribute__((ext_vector_type(16)));
constexpr int TK_KLD = 72, TK_QLD = 1032;
constexpr int TL_KEYS = 0, TL_Q = 36864, TL_IT = 102912;
__device__ __forceinline__ void topk_half(const LAS bf16* KL, const LAS bf16* QL, int c, int h, int lane, float (&res)[16]) {
    const int hh = lane >> 5, r31 = lane & 31;
    f32x16 acc[4];
#ifdef TOPK_VALU
#pragma unroll
    for (int mt = 0; mt < 4; ++mt)
#pragma unroll
        for (int r = 0; r < 16; ++r) acc[mt][r] = 0.f;
#pragma unroll 1
    for (int d = 0; d < 64; ++d) { const float qv = bf2f(QL[r31 * TK_QLD + h * 128 + c * 64 + d]);
#pragma unroll
        for (int mt = 0; mt < 4; ++mt)
#pragma unroll
            for (int r = 0; r < 16; ++r) acc[mt][r] += bf2f(KL[(c * 128 + mt * 32 + (r & 3) + 8 * (r >> 2) + 4 * hh) * TK_KLD + d]) * qv; }
#else
#pragma unroll
    for (int mt = 0; mt < 4; ++mt)
#pragma unroll
        for (int r = 0; r < 16; ++r) acc[mt][r] = 0.f;
#pragma unroll
    for (int ks = 0; ks < 4; ++ks) {
        const bf16x8 bq = *(const LAS bf16x8*)(QL + r31 * TK_QLD + h * 128 + c * 64 + ks * 16 + 8 * hh);
#pragma unroll
        for (int mt = 0; mt < 4; ++mt) { const bf16x8 ak = *(const LAS bf16x8*)(KL + (c * 128 + mt * 32 + r31) * TK_KLD + ks * 16 + 8 * hh);
            acc[mt] = __builtin_amdgcn_mfma_f32_32x32x16_bf16(ak, bq, acc[mt], 0, 0, 0); }
    }
#endif
    float g0[16], g1[16], g2[16], g3[16];
    const unsigned hb = 4u * (unsigned)hh;
#pragma unroll
    for (int r = 0; r < 16; ++r) { const unsigned nc = (unsigned)((r & 3) + 8 * (r >> 2));
        const float a0 = acc[0][r], a1 = acc[1][r], a2 = acc[2][r], a3 = acc[3][r];
        g0[r] = __builtin_bit_cast(float, (__builtin_bit_cast(unsigned, a0) & 0xFFFFFF80u) | ((127u - nc) - hb));
        g1[r] = __builtin_bit_cast(float, (__builtin_bit_cast(unsigned, a1) & 0xFFFFFF80u) | ((127u - 32u - nc) - hb));
        g2[r] = __builtin_bit_cast(float, (__builtin_bit_cast(unsigned, a2) & 0xFFFFFF80u) | ((127u - 64u - nc) - hb));
        g3[r] = __builtin_bit_cast(float, (__builtin_bit_cast(unsigned, a3) & 0xFFFFFF80u) | ((127u - 96u - nc) - hb)); }
    sort16_desc(g0); sort16_desc(g1); sort16_desc(g2); sort16_desc(g3);
    merge16_desc(g0, g1); merge16_desc(g2, g3); merge16_desc(g0, g2);
    float o[16];
#pragma unroll
    for (int i = 0; i < 16; ++i) o[i] = __shfl_xor(g0[i], 32);
    merge16_desc(g0, o);
#pragma unroll
    for (int i = 0; i < 16; ++i) res[i] = g0[i];
}
__device__ __forceinline__ void topk_unit(Frame& F, int unit, const bf16* qp, const float* r2a, int* idx, float* gate) {
    const LAS bf16* KL = (const LAS bf16*)(F.lds + TL_KEYS); LAS bf16* QL = (LAS bf16*)(F.lds + TL_Q);
    LAS unsigned char* ITb = (LAS unsigned char*)(F.lds + TL_IT) + F.wave * 2048 + F.lane * 32;
    const int t0 = unit * 32, tid = F.tid, lane = F.lane, h = F.wave, hh = lane >> 5, r31 = lane & 31;
#pragma unroll
    for (int i = 0; i < 8; ++i) { const int id = tid + 512 * i, r = id >> 7, c16 = id & 127; *(LAS v4u*)(QL + r * TK_QLD + c16 * 8) = *(const v4u*)(qp + (size_t)(t0 + r) * D + c16 * 8); }
    __syncthreads();
    float s0[16], s1[16];
    topk_half(KL, QL, 0, h, lane, s0);
    topk_half(KL, QL, 1, h, lane, s1);
    {
        unsigned w0[4], w1[4];
#pragma unroll
        for (int q = 0; q < 4; ++q) { w0[q] = 0u; w1[q] = 0u;
#pragma unroll
            for (int j = 0; j < 4; ++j) { w0[q] |= (127u - (__builtin_bit_cast(unsigned, s0[q * 4 + j]) & 127u)) << (8 * j); w1[q] |= (127u - (__builtin_bit_cast(unsigned, s1[q * 4 + j]) & 127u)) << (8 * j); } }
        *(LAS v4u*)(ITb) = (v4u){w0[0], w0[1], w0[2], w0[3]}; *(LAS v4u*)(ITb + 16) = (v4u){w1[0], w1[1], w1[2], w1[3]};
    }
#pragma unroll
    for (int i = 0; i < 16; ++i) { s0[i] = __builtin_bit_cast(float, __builtin_bit_cast(unsigned, s0[i]) & 0xFFFFFF80u); s1[i] = __builtin_bit_cast(float, __builtin_bit_cast(unsigned, s1[i]) & 0xFFFFFF80u); }
    float ca[16], cb[16];
    cand_lists(s0, s1, hh != 0, ca, cb);
    sort16_desc(ca); sort16_desc(cb); merge16_desc(ca, cb);
    float o[16];
#pragma unroll
    for (int i = 0; i < 16; ++i) o[i] = __shfl_xor(ca[i], 32);
    merge16_desc(ca, o);
    LDS_WAIT();
    if (hh == 0) {
        float e[16]; int id[16]; float den = 0.f; const float r2 = r2a[t0 + r31];
        const float m = __builtin_bit_cast(float, __builtin_bit_cast(unsigned, ca[0]) & 0xFFFFFF00u);
#pragma unroll
        for (int k = 0; k < 16; ++k) { const unsigned bits = __builtin_bit_cast(unsigned, ca[k]); const unsigned code = 255u - (bits & 255u);
            e[k] = __expf((__builtin_bit_cast(float, bits & 0xFFFFFF00u) - m) * r2); den += e[k];
            const int n0 = ITb[code >> 4], n1 = ITb[16 + (code & 15u)]; id[k] = n0 * 128 + n1; }
        const float inv = 1.f / den;
        int* ip = idx + (size_t)(t0 + r31) * 128 + h * 16; float* gp = gate + (size_t)(t0 + r31) * 128 + h * 16;
#pragma unroll
        for (int q = 0; q < 4; ++q) { *(int4*)(ip + 4 * q) = make_int4(id[4 * q], id[4 * q + 1], id[4 * q + 2], id[4 * q + 3]);
            *(f32x4*)(gp + 4 * q) = (f32x4){e[4 * q] * inv, e[4 * q + 1] * inv, e[4 * q + 2] * inv, e[4 * q + 3] * inv}; }
    }
    __syncthreads();
}

typedef __bf16 bf16x2_t __attribute__((ext_vector_type(2)));
__device__ __forceinline__ float dot2bf(unsigned a, unsigned b, float acc) { return __builtin_amdgcn_fdot2_f32_bf16(__builtin_bit_cast(bf16x2_t, a), __builtin_bit_cast(bf16x2_t, b), acc, false); }
__device__ __forceinline__ float xrow16_sum(float x) {
    auto s = __builtin_amdgcn_permlane16_swap(__float_as_uint(x), __float_as_uint(x), false, false);
    x = __uint_as_float(s[0]) + __uint_as_float(s[1]);
    auto t = __builtin_amdgcn_permlane32_swap(__float_as_uint(x), __float_as_uint(x), false, false);
    return __uint_as_float(t[0]) + __uint_as_float(t[1]);
}
__device__ __forceinline__ float ub0(unsigned u) { float f; asm("v_cvt_f32_ubyte0 %0, %1" : "=v"(f) : "v"(u)); return f; }
__device__ __forceinline__ float ub1(unsigned u) { float f; asm("v_cvt_f32_ubyte1 %0, %1" : "=v"(f) : "v"(u)); return f; }
__device__ __forceinline__ float ub2(unsigned u) { float f; asm("v_cvt_f32_ubyte2 %0, %1" : "=v"(f) : "v"(u)); return f; }
__device__ __forceinline__ float ub3(unsigned u) { float f; asm("v_cvt_f32_ubyte3 %0, %1" : "=v"(f) : "v"(u)); return f; }
__device__ __forceinline__ float wave_max(float v) {
#pragma unroll
    for (int o = 1; o < 64; o <<= 1) v = fmaxf(v, __shfl_xor(v, o));
    return v;
}
__device__ __forceinline__ unsigned q4s(float a, float b, float c, float d, float inv) {
    const int qa = max(-127, min(127, __float2int_rn(a * inv))), qb = max(-127, min(127, __float2int_rn(b * inv))), qc = max(-127, min(127, __float2int_rn(c * inv))), qd = max(-127, min(127, __float2int_rn(d * inv)));
    return (unsigned)(qa & 255) | ((unsigned)(qb & 255) << 8) | ((unsigned)(qc & 255) << 16) | ((unsigned)(qd & 255) << 24);
}
__device__ __forceinline__ void peer_u_token(Frame& F, int t, int j, const signed char* x1q, const float* xsa, const float* r2a, const signed char* ut8, const float* usa, const float* vsa, const int* idx, float* gate, bool dry = false) {
    LAS int* IDXL = (LAS int*)(F.lds + F.wave * 1024);
    LAS unsigned char* LIST = (LAS unsigned char*)(F.lds + F.wave * 1024 + 512);
    const int lane = F.lane, g = lane >> 3, i = lane & 7;
    const int i0 = idx[(size_t)t * 128 + lane], i1 = idx[(size_t)t * 128 + 64 + lane];
    IDXL[lane] = i0; IDXL[64 + lane] = i1;
    const bool b0 = (i0 >> 11) == j, b1 = (i1 >> 11) == j;
    const unsigned long long m0 = __ballot(b0), m1 = __ballot(b1);
    const int n0 = __popcll(m0), n = n0 + __popcll(m1);
    const unsigned long long below = (1ull << lane) - 1ull;
    if (b0) LIST[__popcll(m0 & below)] = (unsigned char)lane;
    if (b1) LIST[n0 + __popcll(m1 & below)] = (unsigned char)(64 + lane);
    v4u hq[8];
    const signed char* hr = x1q + (size_t)t * D + i * 16;
#pragma unroll
    for (int c = 0; c < 8; ++c) hq[c] = *(const v4u*)(hr + c * 128);
    const float sc = r2a[t] * xsa[t];
    LDS_WAIT();
    const int nb = (n + 7) >> 3;
    for (int b = 0; b < nb; ++b) {
        const int q = b * 8 + g; const bool valid = q < n;
        const int slot = LIST[valid ? q : 0];
        const int e = IDXL[slot];
        const signed char* ur = ut8 + (size_t)e * D + i * 16;
        v4u u[8];
#pragma unroll
        for (int c = 0; c < 8; ++c) u[c] = *(const v4u*)(ur + c * 128);
        const float us = usa[e], vs = vsa[e];
        int a0 = 0, a1 = 0, a2 = 0, a3 = 0;
#pragma unroll
        for (int c = 0; c < 8; ++c) { a0 = __builtin_amdgcn_sdot4((int)u[c].x, (int)hq[c].x, a0, false); a1 = __builtin_amdgcn_sdot4((int)u[c].y, (int)hq[c].y, a1, false);
            a2 = __builtin_amdgcn_sdot4((int)u[c].z, (int)hq[c].z, a2, false); a3 = __builtin_amdgcn_sdot4((int)u[c].w, (int)hq[c].w, a3, false); }
        const float d = red8((float)((a0 + a1) + (a2 + a3)));
        if (valid && i == 0 && (!dry || d == 123456.789f)) { const float xx = sc * us * d; float* gp = gate + (size_t)t * 128 + slot; *gp = *gp * (0.5f * xx * (1.f + erff(xx * 0.70710678118654752f))) * vs; }
    }
}
__device__ __forceinline__ void peer_v_token(Frame& F, int t, int j, float* xio, const unsigned char* vt8, const int* idx, const float* wgt, bf16* x2b, float* ss3, bool dry = false) {
    LAS int* IDXL = (LAS int*)(F.lds + F.wave * 1024);
    LAS float* WL = (LAS float*)(F.lds + F.wave * 1024 + 512);
    const int lane = F.lane, q = lane >> 3, i = lane & 7;
    IDXL[lane] = idx[(size_t)t * 128 + lane]; IDXL[64 + lane] = idx[(size_t)t * 128 + 64 + lane];
    WL[lane] = wgt[(size_t)t * 128 + lane]; WL[64 + lane] = wgt[(size_t)t * 128 + 64 + lane];
    LDS_WAIT();
    float acc[17];
#pragma unroll
    for (int d = 0; d < 17; ++d) acc[d] = 0.f;
    const unsigned char* vbase = vt8 + 128 * j + i * 16;
#pragma unroll
    for (int hb = 0; hb < 2; ++hb) {
        v4u v[8]; float w[8];
#pragma unroll
        for (int k = 0; k < 8; ++k) { const int e = IDXL[8 * (hb * 8 + k) + q]; v[k] = *(const v4u*)(vbase + (size_t)e * D); w[k] = WL[8 * (hb * 8 + k) + q]; }
#pragma unroll
        for (int k = 0; k < 8; ++k) { const float wk = w[k]; acc[16] += wk;
            acc[0] += wk * ub0(v[k].x); acc[1] += wk * ub1(v[k].x); acc[2] += wk * ub2(v[k].x); acc[3] += wk * ub3(v[k].x);
            acc[4] += wk * ub0(v[k].y); acc[5] += wk * ub1(v[k].y); acc[6] += wk * ub2(v[k].y); acc[7] += wk * ub3(v[k].y);
            acc[8] += wk * ub0(v[k].z); acc[9] += wk * ub1(v[k].z); acc[10] += wk * ub2(v[k].z); acc[11] += wk * ub3(v[k].z);
            acc[12] += wk * ub0(v[k].w); acc[13] += wk * ub1(v[k].w); acc[14] += wk * ub2(v[k].w); acc[15] += wk * ub3(v[k].w); }
    }
#pragma unroll
    for (int d = 0; d < 17; ++d) { float x = acc[d]; x += dppf<0x128>(x); acc[d] = xrow16_sum(x); }
    float s = 0.f;
    if (q == 0 && (!dry || acc[0] == 123456.789f)) {
        float* xr = xio + (size_t)t * D + 128 * j + i * 16;
        const float off = 128.f * acc[16];
        float o[16];
#pragma unroll
        for (int c4 = 0; c4 < 4; ++c4) { const f32x4 xa = *(const f32x4*)(xr + 4 * c4); o[4 * c4] = xa.x + acc[4 * c4] - off; o[4 * c4 + 1] = xa.y + acc[4 * c4 + 1] - off; o[4 * c4 + 2] = xa.z + acc[4 * c4 + 2] - off; o[4 * c4 + 3] = xa.w + acc[4 * c4 + 3] - off; }
#pragma unroll
        for (int c4 = 0; c4 < 4; ++c4) *(f32x4*)(xr + 4 * c4) = (f32x4){o[4 * c4], o[4 * c4 + 1], o[4 * c4 + 2], o[4 * c4 + 3]};
        v4u p0, p1; p0.x = pk2(o[0], o[1]); p0.y = pk2(o[2], o[3]); p0.z = pk2(o[4], o[5]); p0.w = pk2(o[6], o[7]); p1.x = pk2(o[8], o[9]); p1.y = pk2(o[10], o[11]); p1.z = pk2(o[12], o[13]); p1.w = pk2(o[14], o[15]);
        *(v4u*)(x2b + (size_t)t * D + 128 * j + i * 16) = p0; *(v4u*)(x2b + (size_t)t * D + 128 * j + i * 16 + 8) = p1;
#pragma unroll
        for (int d = 0; d < 16; ++d) s += o[d] * o[d];
    }
    s = red8(s);
    if (lane == 0 && (!dry || s == 123456.789f)) atomicAdd(ss3 + t, s);
}

#ifndef PG8_SP2
#define PG8_SP2 true
#endif
#ifndef PG8_ALIGN
#define PG8_ALIGN true
#endif
template <class E> __device__ __forceinline__ void run_gemm(Frame& F, const bf16* A, const bf16* Bt, int M, int N, int K, const E& e) {
    pg8::Gemm g{A, Bt, M, N, K}; pg8::StaticOrder S; S.init(M, N, F.G, (int)blockIdx.x);
    EpiAdapt<E> EA{e};
    pg8::gemm_phase<EpiAdapt<E>, pg8::StaticOrder, PG8_ALIGN, PG8_SP2>(F.lds + RING_OFF, g, S, EA);
}

__global__ void __launch_bounds__(NTHR, 2) fwd(Args args) {
    extern __shared__ __attribute__((aligned(16))) unsigned char lds_raw[];
    Frame F;
    F.lds = (LAS unsigned char*)lds_raw;
    F.tid = threadIdx.x; F.lane = F.tid & 63; F.wave = __builtin_amdgcn_readfirstlane(F.tid >> 6);
    F.G = gridDim.x; { const int bx = blockIdx.x; F.vcu = (F.G % 8 == 0) ? (bx % 8) * (F.G / 8) + bx / 8 : bx; }
    unsigned char* ws = args.ws; unsigned char* dout = (unsigned char*)args.out;
    unsigned* ctl = (unsigned*)(ws + WS_CTL);
    for (int u = F.tid; u < (LDS_BYTES - LDSCTL_OFF) / 4; u += NTHR) ((LAS unsigned*)(F.lds + LDSCTL_OFF))[u] = 0u;
    __syncthreads();
    volatile LAS unsigned* MISC = (volatile LAS unsigned*)(F.lds + MISC_OFF);
    XcdBarrier bar = xcd_barrier_post(ctl + CW_BAR + args.li * XCD_BAR_WORDS, MISC + 8);
    const int lo = args.ph_lo, hi = args.ph_hi;
#ifndef PHMASK
#define PHMASK 0xFFFFFFFFu
#endif
#define IN(k) ((((PHMASK) >> (k)) & 1u) && lo <= (k) && (k) < hi)
#ifndef REPMASK
#define REPMASK 0u
#endif
#define NREP(k) (1 + (int)(((REPMASK) >> (k)) & 1u))
#define SEAM(k) do { if (IN(k) && IN((k) + 1)) xcd_barrier(bar); } while (0)

    const float* const* in = args.in;
    float* SS3 = (float*)(ws + CTL_SS3);
    float* R1 = (float*)(ws + SM_R1); float* R2 = (float*)(ws + SM_R3); float* LB = (float*)(ws + SM_LB); float* BONUS = (float*)(ws + SM_BONUS);
    bf16 *WIN = (bf16*)(ws + WS_WIN), *WBH = (bf16*)(ws + WS_WBH), *WBR = (bf16*)(ws + WS_WBR), *WOUT = (bf16*)(ws + WS_WOUT), *WQ = (bf16*)(ws + WS_WQ), *WPG = (bf16*)(ws + WS_WPG),
         *WPP = (bf16*)(ws + WS_WPP), *WLORA = (bf16*)(ws + WS_WLORA);
    bf16 *XB = (bf16*)(ws + WS_XB), *LW = (bf16*)(ws + WS_LW), *AA = (bf16*)(ws + WS_A), *YRW = (bf16*)(ws + WS_YRW), *PB = (bf16*)(ws + WS_PB);
    bf16 *CQ = (bf16*)(ws + WS_CQ), *M1 = (bf16*)(ws + WS_M1), *MERGED = (bf16*)(ws + WS_MERGED), *UT = (bf16*)(ws + WS_UT), *VT = (bf16*)(ws + WS_VT);
    bf16 *CRW = (bf16*)(ws + WS_CRW), *G = (bf16*)(ws + WS_G), *YRAW = (bf16*)(ws + WS_YRAW); int* IDX = (int*)(ws + WS_IDX); float* GATE = (float*)(ws + WS_GATE);
    signed char* UT8 = (signed char*)(ws + WS_CQ); unsigned char* VT8 = (unsigned char*)(ws + WS_CQ + 16 * MiB); signed char* X1Q = (signed char*)(ws + WS_CQ + 32 * MiB);
    float* US = (float*)(ws + WS_SMALL + 768 * 1024); float* VS = (float*)(ws + WS_SMALL + 832 * 1024); float* XS = (float*)(ws + WS_SMALL + 896 * 1024);
    float* HST = (float*)(ws + WS_HST); float* HD = (float*)(ws + WS_HST + 16 * MiB);
    bf16 *CG = (bf16*)(ws + WS_CG), *X1B = (bf16*)(ws + WS_X1B), *QP = (bf16*)(ws + WS_QP), *X2B = (bf16*)(ws + WS_X2B), *T2 = (bf16*)(ws + WS_T2);
    bf16 *RR = (bf16*)(dout + DO_R), *KK = (bf16*)(dout + DO_K), *VV = (bf16*)(dout + DO_V), *LIN = (bf16*)(dout + DO_LIN), *YHG = (bf16*)(dout + DO_YHG);
    float* XO = args.out;
    const int gw = F.vcu * NWAVES + F.wave, NGW = F.G * NWAVES;
    const size_t gtid = (size_t)F.vcu * NTHR + F.tid, NGT = (size_t)F.G * NTHR;

    if (IN(PH_PRO)) for (int rep0 = 0; rep0 < NREP(PH_PRO); ++rep0) {
        LAS float* scr = (LAS float*)(F.lds + RING_OFF + F.wave * 16384);
        constexpr int I_IN = (D / 64) * (INC / 32), I_B = (512 / 64) * (D / 32), I_SQ = (D / 64) * (D / 32), I_PP = (PLE / 64) * (D / 32), I_L64 = 1 * (512 / 32), I_L128 = 2 * (512 / 32);
        constexpr int NITEMS = I_IN + 2 * I_B + 3 * I_SQ + I_PP + 2 * I_L64 + I_L128;
        for (int it = gw; it < NITEMS; it += NGW) {
            int r = it;
            if (r < I_IN) { tr_item(in[3], in[2], D, INC, WIN, D, 0, 0, scr, r, F.lane); continue; } r -= I_IN;
            if (r < I_B) { tr_item(in[17], nullptr, 512, D, WBH, 512, 0, 0, scr, r, F.lane); continue; } r -= I_B;
            if (r < I_B) { tr_item(in[18], nullptr, 512, D, WBR, 512, 0, 0, scr, r, F.lane); continue; } r -= I_B;
            if (r < I_SQ) { tr_item(in[19], nullptr, D, D, WOUT, D, 0, 0, scr, r, F.lane); continue; } r -= I_SQ;
            if (r < I_SQ) { tr_item(in[21], in[20], D, D, WQ, D, 0, 0, scr, r, F.lane); continue; } r -= I_SQ;
            if (r < I_SQ) { tr_item(in[27], in[25], D, D, WPG, D, 0, 0, scr, r, F.lane); continue; } r -= I_SQ;
            if (r < I_PP) { tr_item(in[26], nullptr, PLE, D, WPP, PLE, 0, 0, scr, r, F.lane); continue; } r -= I_PP;
            if (r < I_L64) { tr_item(in[8], nullptr, 64, 512, WLORA, 256, 0, 0, scr, r, F.lane); continue; } r -= I_L64;
            if (r < I_L64) { tr_item(in[10], nullptr, 64, 512, WLORA, 256, 64, 512, scr, r, F.lane); continue; } r -= I_L64;
            tr_item(in[11], nullptr, 128, 512, WLORA, 256, 128, 1024, scr, r, F.lane);
        }
        for (size_t c = gtid; c < (size_t)1536 * 32; c += NGT) {
            const int row = (int)(c / 32), col = (int)(c % 32) * 8, blk = row / 512;
            const bool diag = (blk == 0 && col < 64) || (blk == 1 && col >= 64 && col < 128) || (blk == 2 && col >= 128);
            if (!diag) *(v4u*)(WLORA + (size_t)row * 256 + col) = (v4u){0u, 0u, 0u, 0u};
        }
        if (F.vcu == 0) { const int c = F.tid; const float a = in[4][c], b = in[4][512 + c], m = fmaxf(a, b); const float ea = __expf(a - m), eb = __expf(b - m); LB[c] = ea / (ea + eb); }
        for (int m = gw; m < T; m += NGW) xprep_row(in[0], XB, R1, m, F.lane);
        for (size_t c = gtid; c < (size_t)T * PLE / 8; c += NGT) {
            const f32x4 a = ((const f32x4*)in[1])[2 * c], b = ((const f32x4*)in[1])[2 * c + 1];
            v4u w; w.x = pk2(a.x, a.y); w.y = pk2(a.z, a.w); w.z = pk2(b.x, b.y); w.w = pk2(b.z, b.w);
            ((v4u*)PB)[c] = w;
        }
    }
    SEAM(PH_PRO);
    if (IN(PH_GEMM1)) { run_gemm(F, XB, WIN, T, INC, D, EpiIn{R1, LB, CQ, CRW, CG}); if (NREP(PH_GEMM1) > 1) run_gemm(F, XB, WIN, T, INC, D, EpiIn{R1, LB, CQ, CRW, CG}); }
    SEAM(PH_GEMM1);
    if (IN(PH_RWSHIFT)) for (int rep2 = 0; rep2 < NREP(PH_RWSHIFT); ++rep2) {
        const float* mu = in[6];
        for (size_t c = gtid; c < (size_t)T * (RWC / 8); c += NGT) {
            const int t = (int)(c / (RWC / 8)), col = (int)(c % (RWC / 8)) * 8;
            float cur[8], prev[8], o[8];
            unpack8(*(const v4u*)(CRW + (size_t)t * RWC + col), cur);
            if (t % SEQ) unpack8(*(const v4u*)(CRW + (size_t)(t - 1) * RWC + col), prev);
            else {
#pragma unroll
                for (int j = 0; j < 8; ++j) prev[j] = 0.f; }
#pragma unroll
            for (int j = 0; j < 8; ++j) o[j] = cur[j] + (prev[j] - cur[j]) * mu[col + j];
            if (col < 512) *(v4u*)(RR + (size_t)t * 512 + col) = pack8(o);
            else if (col < 1024) *(v4u*)(KK + (size_t)t * 512 + col - 512) = pack8(o);
            else if (col < 1536) *(v4u*)(VV + (size_t)t * 512 + col - 1024) = pack8(o);
            else {
                if (col < 1600) {
#pragma unroll
                    for (int j = 0; j < 8; ++j) o[j] = tanhf(o[j]);
                } else if (col >= 1664) {
#pragma unroll
                    for (int j = 0; j < 8; ++j) o[j] = sigmoidf_(o[j]);
                }
                *(v4u*)(LIN + (size_t)t * 256 + col - 1536) = pack8(o);
            }
        }
    }
    SEAM(PH_RWSHIFT);
    if (IN(PH_LORA)) {
        run_gemm(F, LIN, WLORA, T, 1536, 256, EpiLora{in[7], in[9], LW, AA, G});
        if (NREP(PH_LORA) > 1) run_gemm(F, LIN, WLORA, T, 1536, 256, EpiLora{in[7], in[9], LW, AA, G});
        for (int u = F.vcu; u < 256; u += F.G) hgrn_unit<false>(F, u, CQ, in[5], YHG, HST, HD);
    }
    SEAM(PH_LORA);
    if (IN(PH_HGRN)) {
        for (int rep = 0; rep < NREP(PH_HGRN); ++rep)
        for (int u = F.vcu; u < 256; u += F.G) hgrn_unit<true>(F, u, CQ, in[5], YHG, HST, HD);
    }
    SEAM(PH_HGRN);
    if (IN(PH_RWKV)) {
        for (int rep = 0; rep < NREP(PH_RWKV); ++rep)
        for (int item = F.vcu; item < BATCH * RWH * 4; item += F.G) rwkv_item(F, item, RR, KK, VV, LW, AA, in[12], in[13], in[14], YRAW, BONUS);
    }
    SEAM(PH_RWKV);
    if (IN(PH_RWPOST)) for (int rep6 = 0; rep6 < NREP(PH_RWPOST); ++rep6) {
        const float* ln_w = in[15]; const float* ln_b = in[16];
        for (int w = gw; w < T * RWH; w += NGW) {
            const int t = w / RWH, h = w % RWH, c = h * 64 + F.lane; const size_t o = (size_t)t * 512 + c;
            const float y = bf2f(YRAW[o]);
            const float mean = wave_sum(y) * (1.f / 64.f); const float d = y - mean; const float var = wave_sum(d * d) * (1.f / 64.f);
            float r = d * rsqrtf(var + GN_EPS) * ln_w[c] + ln_b[c];
            r = (r + BONUS[(size_t)t * 8 + h] * bf2f(VV[o])) * bf2f(G[o]);
            YRW[o] = (bf16)f2bf(r);
        }
    }
    SEAM(PH_RWPOST);
    if (IN(PH_BR)) {
        run_gemm(F, YHG, WBH, T, D, 512, EpiBranch1{CG, M1});
        run_gemm(F, YRW, WBR, T, D, 512, EpiBranch2{CG, M1, MERGED});
        if (NREP(PH_BR) > 1) { run_gemm(F, YHG, WBH, T, D, 512, EpiBranch1{CG, M1}); run_gemm(F, YRW, WBR, T, D, 512, EpiBranch2{CG, M1, MERGED}); }
    }
    SEAM(PH_BR);
    if (IN(PH_OUT)) { run_gemm(F, MERGED, WOUT, T, D, D, EpiOut{in[0], XO, X1B}); if (NREP(PH_OUT) > 1) run_gemm(F, MERGED, WOUT, T, D, D, EpiOut{in[0], XO, X1B}); }
    SEAM(PH_OUT);
    if (IN(PH_QG)) {
        run_gemm(F, X1B, WQ, T, D, D, EpiQ{QP});
        if (NREP(PH_QG) > 1) run_gemm(F, X1B, WQ, T, D, D, EpiQ{QP});
        for (int m = gw; m < T; m += NGW) {
            const v4u a = *(const v4u*)(X1B + (size_t)m * D + F.lane * 8), b = *(const v4u*)(X1B + (size_t)m * D + 512 + F.lane * 8); float fa[8], fb[8]; unpack8(a, fa); unpack8(b, fb); float sq = 0.f, mx = 0.f;
#pragma unroll
            for (int q = 0; q < 8; ++q) { sq += fa[q] * fa[q] + fb[q] * fb[q]; mx = fmaxf(mx, fmaxf(fabsf(fa[q]), fabsf(fb[q]))); }
            sq = wave_sum(sq); mx = wave_max(mx);
            const float inv = mx > 0.f ? 127.f / mx : 0.f;
            v2u qa, qb; qa.x = q4s(fa[0], fa[1], fa[2], fa[3], inv); qa.y = q4s(fa[4], fa[5], fa[6], fa[7], inv); qb.x = q4s(fb[0], fb[1], fb[2], fb[3], inv); qb.y = q4s(fb[4], fb[5], fb[6], fb[7], inv);
            *(v2u*)(X1Q + (size_t)m * D + F.lane * 8) = qa; *(v2u*)(X1Q + (size_t)m * D + 512 + F.lane * 8) = qb;
            if (F.lane == 0) { R2[m] = rsqrtf(sq * (1.f / D) + RMS_EPS); XS[m] = mx * (1.f / 127.f); } }
        for (int item = gw; item < 2 * NEXP; item += NGW) {
            const int tb = item >= NEXP, e = item - tb * NEXP;
            const float* src = (tb ? in[24] : in[23]) + (size_t)e * D;
            f32x4 x[4]; float mx = 0.f;
#pragma unroll
            for (int jj = 0; jj < 4; ++jj) { x[jj] = *(const f32x4*)(src + F.lane * 4 + 256 * jj);
                if (!tb) { const f32x4 wv = *(const f32x4*)(in[20] + F.lane * 4 + 256 * jj); x[jj].x *= wv.x; x[jj].y *= wv.y; x[jj].z *= wv.z; x[jj].w *= wv.w; }
                mx = fmaxf(mx, fmaxf(fmaxf(fabsf(x[jj].x), fabsf(x[jj].y)), fmaxf(fabsf(x[jj].z), fabsf(x[jj].w)))); }
            mx = wave_max(mx);
            const float inv = mx > 0.f ? 127.f / mx : 0.f;
            unsigned* dst = (unsigned*)((tb ? (unsigned char*)VT8 : (unsigned char*)UT8) + (size_t)e * D);
#pragma unroll
            for (int jj = 0; jj < 4; ++jj) { unsigned qv = q4s(x[jj].x, x[jj].y, x[jj].z, x[jj].w, inv); if (tb) qv ^= 0x80808080u; dst[F.lane + 64 * jj] = qv; }
            if (F.lane == 0) (tb ? VS : US)[e] = mx * (1.f / 127.f);
        }
    }
    SEAM(PH_QG);
    if (IN(PH_TOPK)) {
        {
            LAS bf16* KL = (LAS bf16*)(F.lds + TL_KEYS);
#pragma unroll
            for (int i = 0; i < 8; ++i) { const int id = F.tid + 512 * i, row = id >> 4, c4 = (id & 15) * 4; const f32x4 kv = *(const f32x4*)(in[22] + (size_t)row * 64 + c4);
                v2u pk; pk.x = pk2(kv.x, kv.y); pk.y = pk2(kv.z, kv.w); *(LAS v2u*)(KL + row * TK_KLD + c4) = pk; }
        }
        for (int rep = 0; rep < NREP(PH_TOPK); ++rep)
        for (int unit = F.vcu; unit < T / 32; unit += F.G) topk_unit(F, unit, QP, R2, IDX, GATE);
        __syncthreads();
    }
    SEAM(PH_TOPK);
    if (IN(PH_GU)) {
        const int j = blockIdx.x & 7, nper = F.G >> 3;
        for (int rep = NREP(PH_GU) - 1; rep >= 0; --rep)
        for (int t = (blockIdx.x >> 3) * NWAVES + F.wave; t < T; t += nper * NWAVES) peer_u_token(F, t, j, X1Q, XS, R2, UT8, US, VS, IDX, GATE, rep > 0);
    }
    SEAM(PH_GU);
    if (IN(PH_GV)) {
        const int j = blockIdx.x & 7, nper = F.G >> 3;
        for (int rep = NREP(PH_GV) - 1; rep >= 0; --rep)
        for (int t = (blockIdx.x >> 3) * NWAVES + F.wave; t < T; t += nper * NWAVES) peer_v_token(F, t, j, XO, VT8, IDX, GATE, X2B, SS3, rep > 0);
    }
    SEAM(PH_GV);
    if (IN(PH_PLE)) {
        run_gemm(F, PB, WPP, T, D, PLE, EpiPP{T2});
        run_gemm(F, X2B, WPG, T, D, D, EpiPG{SS3, T2, XO});
    }
    SEAM(PH_PLE);
    if (NREP(15) > 1) { for (int xb = 0; xb < 16; ++xb) xcd_barrier(bar); }
    if (IN(PH_FINAL)) {
        const float* fw = in[28];
        for (int row = gw; row < T; row += NGW) {
            f32x4* xr = (f32x4*)(XO + (size_t)row * D) + F.lane; const f32x4* w = (const f32x4*)fw + F.lane;
            f32x4 v[4]; float sq = 0.f;
#pragma unroll
            for (int j = 0; j < 4; ++j) { v[j] = xr[64 * j]; sq += (v[j].x * v[j].x + v[j].y * v[j].y) + (v[j].z * v[j].z + v[j].w * v[j].w); }
            const float r = rsqrtf(wave_sum(sq) * (1.f / D) + RMS_EPS);
#pragma unroll
            for (int j = 0; j < 4; ++j) { const f32x4 ww = w[64 * j]; f32x4 o = v[j]; o.x *= r * ww.x; o.y *= r * ww.y; o.z *= r * ww.z; o.w *= r * ww.w; xr[64 * j] = o; }
        }
    }
#undef IN
#undef SEAM
}

extern "C" void kernel_launch(void* const* d_in, const int* in_sizes, int n_in, void* d_out, int out_size, void* d_ws, size_t ws_size, hipStream_t stream) {
    static int grid = 0;
    if (grid == 0) {
        if (n_in != 29 || ws_size < WS_END || out_size != T * D) { fprintf(stderr, "kernel_launch: unexpected n_in %d / ws %zu / out %d\n", n_in, ws_size, out_size); grid = -1; return; }
        int dev = 0, cus = 0, per_cu = 0;
        if (hipGetDevice(&dev) != hipSuccess || hipDeviceGetAttribute(&cus, hipDeviceAttributeMultiprocessorCount, dev) != hipSuccess) { grid = -1; return; }
        if (hipFuncSetAttribute((const void*)fwd, hipFuncAttributeMaxDynamicSharedMemorySize, LDS_BYTES) != hipSuccess) { fprintf(stderr, "kernel_launch: hipFuncSetAttribute failed\n"); grid = -1; return; }
        if (hipOccupancyMaxActiveBlocksPerMultiprocessor(&per_cu, (const void*)fwd, NTHR, LDS_BYTES) != hipSuccess || per_cu < 1) fprintf(stderr, "kernel_launch: occupancy query says %d\n", per_cu);
        (void)hipGetLastError();
        grid = cus;
    }
    if (grid < 0) return;
    unsigned char* ws = (unsigned char*)d_ws; unsigned char* dout = (unsigned char*)d_out;
    (void)hipMemsetAsync(ws + WS_CTL, 0, CTL_ZERO_BYTES, stream);
    Args a{};
    for (int i = 0; i < 29; ++i) a.in[i] = (const float*)d_in[i];
    a.out = (float*)d_out; a.ws = ws;
    int li = 0;
    auto run = [&](int lo, int hi) { a.ph_lo = lo; a.ph_hi = hi; a.li = li++; hipLaunchKernelGGL(fwd, dim3(grid), dim3(NTHR), LDS_BYTES, stream, a); };
    const float* const* in = (const float* const*)d_in;
    bf16 *LW = (bf16*)(ws + WS_LW), *AA = (bf16*)(ws + WS_A), *CQ = (bf16*)(ws + WS_CQ), *YRAW = (bf16*)(ws + WS_YRAW), *QP = (bf16*)(ws + WS_QP);
    bf16 *RR = (bf16*)(dout + DO_R), *KK = (bf16*)(dout + DO_K), *VV = (bf16*)(dout + DO_V), *YHG = (bf16*)(dout + DO_YHG);
    int* IDX = (int*)(ws + WS_IDX); float* GATE = (float*)(ws + WS_GATE); float* BONUS = (float*)(ws + SM_BONUS);
    run(PH_PRO, PH_N);
}
```
